# Optimizing an MI355X kernel written in HIP

```python
import math
import jax
import jax.numpy as jnp
from jax import lax
import numpy as np

D_MODEL = 1024
BATCH = 8
SEQ = 2048
DEPTH = 2

GRID_W = 64
CTX_LEN = 256
HEAD_DIM = 64
A_HEADS = 6
A_KV_HEADS = 2
WINDOW = 128
WIN_BLK = 128
B_HEADS = 4
B_QK_DIM = 32
C_HEADS = 6
NA_KH = 8
NA_KW = 16
Q_BLK = 128
N_MOD = 6
D_FF_RAW = -(-8 * D_MODEL // 3)
D_FF = -(-D_FF_RAW // 256) * 256
MIX_WIDTH = (A_HEADS + B_HEADS + C_HEADS) * HEAD_DIM
A_Q_W = A_HEADS * HEAD_DIM
A_KV_W = A_KV_HEADS * HEAD_DIM
B_QK_W = B_HEADS * 2 * B_QK_DIM
B_V_W = B_HEADS * HEAD_DIM
C_W = C_HEADS * HEAD_DIM
PROJ_WIDTH = A_Q_W + 2 * A_KV_W + 2 * B_QK_W + B_V_W + 3 * C_W
ROPE_BASE = 10000.0
LN_EPS = 1e-5
NEG_INF = -1e30

kernel_name = "hybrid_dit_parallel_head_groups"


def layer_norm(x, g, b):
    xf = x.astype(jnp.float32)
    mu = jnp.mean(xf, axis=-1, keepdims=True)
    var = jnp.mean(jnp.square(xf - mu), axis=-1, keepdims=True)
    return ((xf - mu) * lax.rsqrt(var + LN_EPS) * g + b).astype(x.dtype)


def rms_norm(x, g):
    xf = x.astype(jnp.float32)
    return (xf * lax.rsqrt(jnp.mean(jnp.square(xf), axis=-1, keepdims=True) + LN_EPS) * g).astype(x.dtype)


def modulate(t, shift, scale):
    return t * (1.0 + scale) + shift


def post_norm(res, y, gate, g, b, alpha):
    return layer_norm(alpha * res + gate * y, g, b)


def swiglu(h, w_in_l, w_out_l):
    gate, up = jnp.split(h @ w_in_l, 2, axis=-1)
    return (jax.nn.silu(gate) * up) @ w_out_l


def rope_1d(x, pos):
    half = x.shape[-1] // 2
    inv = ROPE_BASE ** (-jnp.arange(half, dtype=jnp.float32) / half)
    ang = pos.astype(jnp.float32)[:, None] * inv[None, :]
    cos = jnp.cos(ang)[:, None, :]
    sin = jnp.sin(ang)[:, None, :]
    x1 = x[..., :half].astype(jnp.float32)
    x2 = x[..., half:].astype(jnp.float32)
    return jnp.concatenate([x1 * cos - x2 * sin, x2 * cos + x1 * sin], axis=-1).astype(x.dtype)


def rope_2d(x, rows, cols):
    d = x.shape[-1]
    return jnp.concatenate([rope_1d(x[..., : d // 2], rows), rope_1d(x[..., d // 2:], cols)], axis=-1)


def split_proj(p):
    B, L, _ = p.shape
    widths = (A_Q_W, A_KV_W, A_KV_W, B_QK_W, B_QK_W, B_V_W, C_W, C_W, C_W)
    offs = [sum(widths[:i]) for i in range(1, len(widths))]
    aq, ak, av, bq, bk, bv, cq, ck, cv = jnp.split(p, offs, axis=-1)
    return (aq.reshape(B, L, A_HEADS, HEAD_DIM),
            ak.reshape(B, L, A_KV_HEADS, HEAD_DIM),
            av.reshape(B, L, A_KV_HEADS, HEAD_DIM),
            bq.reshape(B, L, B_HEADS, 2, B_QK_DIM),
            bk.reshape(B, L, B_HEADS, 2, B_QK_DIM),
            bv.reshape(B, L, B_HEADS, HEAD_DIM),
            cq.reshape(B, L, C_HEADS, HEAD_DIM),
            ck.reshape(B, L, C_HEADS, HEAD_DIM),
            cv.reshape(B, L, C_HEADS, HEAD_DIM))


def context_attention(q, k, v, sink=None):
    B, C, HQ, d = q.shape
    G = k.shape[2]
    R = HQ // G
    qg = q.reshape(B, C, G, R, d)
    s = jnp.einsum('bqgrd,bkgd->bgrqk', qg, k).astype(jnp.float32) * (d ** -0.5)
    if sink is not None:
        sk = jnp.broadcast_to(sink.reshape(G, R)[None, :, :, None, None].astype(jnp.float32), (B, G, R, C, 1))
        s = jnp.concatenate([s, sk], axis=-1)
    p = jax.nn.softmax(s, axis=-1)[..., :C]
    return jnp.einsum('bgrqk,bkgd->bqgrd', p, v).reshape(B, C, HQ * d).astype(q.dtype)


def window_gqa(q, k, v, kc, vc, sink):
    B, L, HQ, d = q.shape
    G = A_KV_HEADS
    R = HQ // G
    nb = L // WIN_BLK
    C = kc.shape[1]
    qb = q.reshape(B, nb, WIN_BLK, G, R, d)
    pad = ((0, 0), (WIN_BLK, WIN_BLK), (0, 0), (0, 0))
    kp = jnp.pad(k, pad)
    vp = jnp.pad(v, pad)

    def bands(t):
        return jnp.concatenate([t[:, j * WIN_BLK: j * WIN_BLK + L].reshape(B, nb, WIN_BLK, G, d) for j in range(3)], axis=2)

    kb, vb = bands(kp), bands(vp)
    scale = d ** -0.5
    s_win = jnp.einsum('bnqgrd,bnkgd->bgrnqk', qb, kb).astype(jnp.float32) * scale
    s_ctx = jnp.einsum('bnqgrd,bcgd->bgrnqc', qb, kc).astype(jnp.float32) * scale
    blk = jnp.arange(nb, dtype=jnp.int32)[:, None] * WIN_BLK
    qpos = blk + jnp.arange(WIN_BLK, dtype=jnp.int32)[None, :]
    kpos = blk - WIN_BLK + jnp.arange(3 * WIN_BLK, dtype=jnp.int32)[None, :]
    valid = ((jnp.abs(qpos[:, :, None] - kpos[:, None, :]) <= WINDOW)
             & (kpos >= 0)[:, None, :] & (kpos < L)[:, None, :])
    s_win = jnp.where(valid, s_win, NEG_INF)
    sk = jnp.broadcast_to(sink.reshape(G, R)[None, :, :, None, None, None].astype(jnp.float32), (B, G, R, nb, WIN_BLK, 1))
    p = jax.nn.softmax(jnp.concatenate([s_win, s_ctx, sk], axis=-1), axis=-1)
    pw = p[..., : 3 * WIN_BLK]
    pc = p[..., 3 * WIN_BLK: 3 * WIN_BLK + C]
    out = jnp.einsum('bgrnqk,bnkgd->bnqgrd', pw, vb) + jnp.einsum('bgrnqc,bcgd->bnqgrd', pc, vc)
    return out.reshape(B, L, HQ * d).astype(q.dtype)


def diff_core(q, k, v, lam):
    s = jnp.einsum('bqhmd,bkhmd->bhmqk', q, k).astype(jnp.float32) * (q.shape[-1] ** -0.5)
    p = jax.nn.softmax(s, axis=-1)
    a = p[:, :, 0] - lam * p[:, :, 1]
    return jnp.einsum('bhqk,bkhd->bqhd', a, v)


def diff_head_norm(o, g, lam_init):
    B, L = o.shape[:2]
    return (rms_norm(o, g) * (1.0 - lam_init)).reshape(B, L, B_HEADS * HEAD_DIM)


def diff_attention_latent(q, k, v, kc, vc, lam, g, lam_init):
    B, L = q.shape[:2]
    nb = L // Q_BLK
    k_all = jnp.concatenate([kc, k], axis=1)
    v_all = jnp.concatenate([vc, v], axis=1)
    qb = jnp.swapaxes(q.reshape(B, nb, Q_BLK, B_HEADS, 2, B_QK_DIM), 0, 1)
    ob = lax.map(lambda qblk: diff_core(qblk, k_all, v_all, lam), qb)
    o = jnp.swapaxes(ob, 0, 1).reshape(B, L, B_HEADS, HEAD_DIM)
    return diff_head_norm(o, g, lam_init)


def neighbourhood_attention(q, k, v, kc, vc, rel_bias):
    B, L, H, d = q.shape
    W = GRID_W
    R = L // W
    KH = min(NA_KH, R)
    qg, kg, vg = (t.reshape(B, R, W, H, d) for t in (q, k, v))
    r = jnp.arange(R, dtype=jnp.int32)
    rs = jnp.clip(r - KH // 2, 0, R - KH)
    row_idx = rs[:, None] + jnp.arange(KH, dtype=jnp.int32)[None, :]
    kr = kg[:, row_idx]
    vr = vg[:, row_idx]
    cq = jnp.arange(W, dtype=jnp.int32)
    cs = jnp.clip(cq - NA_KW // 2, 0, W - NA_KW)
    col_valid = (cq[None, :] >= cs[:, None]) & (cq[None, :] < cs[:, None] + NA_KW)
    dr = row_idx - r[:, None] + (NA_KH - 1)
    dc = jnp.clip(cq[None, :] - cq[:, None], -(NA_KW - 1), NA_KW - 1) + (NA_KW - 1)
    bias = rel_bias[:, dr[:, None, :, None], dc[None, :, None, :]].astype(jnp.float32)
    scale = d ** -0.5
    s_win = jnp.einsum('brwhd,brkvhd->bhrwkv', qg, kr).astype(jnp.float32) * scale + bias
    s_win = jnp.where(col_valid[:, None, :], s_win, NEG_INF).reshape(B, H, R, W, KH * W)
    s_ctx = jnp.einsum('brwhd,bchd->bhrwc', qg, kc).astype(jnp.float32) * scale
    p = jax.nn.softmax(jnp.concatenate([s_win, s_ctx], axis=-1), axis=-1)
    pw = p[..., : KH * W].reshape(B, H, R, W, KH, W)
    pc = p[..., KH * W:]
    out = jnp.einsum('bhrwkv,brkvhd->brwhd', pw, vr) + jnp.einsum('bhrwc,bchd->brwhd', pc, vc)
    return out.reshape(B, L, H * d).astype(q.dtype)


def setup_inputs(seed: int = 0) -> dict:
    key = jax.random.key(seed)
    ks = jax.random.split(key, 24)
    f32 = jnp.float32
    beta = (8.0 * DEPTH) ** -0.25

    def nrm(k, shape, scale):
        return jax.random.normal(k, shape, f32) * scale

    return {
        "x": nrm(ks[0], (BATCH, SEQ, D_MODEL), 1.0),
        "c": nrm(ks[1], (BATCH, D_MODEL), 1.0),
        "ctx": nrm(ks[2], (BATCH, CTX_LEN, D_MODEL), 1.0),
        "c_ctx": nrm(ks[3], (D_MODEL,), 1.0),
        "w_ada": nrm(ks[4], (DEPTH, D_MODEL, N_MOD * D_MODEL), 0.5 * D_MODEL ** -0.5),
        "b_ada": nrm(ks[5], (DEPTH, N_MOD * D_MODEL), 0.02),
        "w_in": nrm(ks[6], (DEPTH, D_MODEL, PROJ_WIDTH), D_MODEL ** -0.5),
        "w_o": nrm(ks[7], (DEPTH, MIX_WIDTH, D_MODEL), beta * MIX_WIDTH ** -0.5),
        "sink": nrm(ks[8], (DEPTH, A_HEADS), 0.5),
        "lam_q1": nrm(ks[9], (DEPTH, B_QK_DIM), 0.1),
        "lam_k1": nrm(ks[10], (DEPTH, B_QK_DIM), 0.1),
        "lam_q2": nrm(ks[11], (DEPTH, B_QK_DIM), 0.1),
        "lam_k2": nrm(ks[12], (DEPTH, B_QK_DIM), 0.1),
        "subln_g": 1.0 + nrm(ks[13], (DEPTH, HEAD_DIM), 0.02),
        "na_bias": nrm(ks[14], (DEPTH, C_HEADS, 2 * NA_KH - 1, 2 * NA_KW - 1), 0.1),
        "ln1_g": 1.0 + nrm(ks[15], (DEPTH, D_MODEL), 0.02),
        "ln1_b": nrm(ks[16], (DEPTH, D_MODEL), 0.02),
        "w_ffn_in": nrm(ks[17], (DEPTH, D_MODEL, 2 * D_FF), D_MODEL ** -0.5),
        "w_ffn_out": nrm(ks[18], (DEPTH, D_FF, D_MODEL), beta * D_FF ** -0.5),
        "ln2_g": 1.0 + nrm(ks[19], (DEPTH, D_MODEL), 0.02),
        "ln2_b": nrm(ks[20], (DEPTH, D_MODEL), 0.02),
    }


def reference(x, c, ctx, c_ctx, w_ada, b_ada, w_in, w_o, sink, lam_q1, lam_k1, lam_q2, lam_k2,
              subln_g, na_bias, ln1_g, ln1_b, w_ffn_in, w_ffn_out, ln2_g, ln2_b):
    B, L, _ = x.shape
    tpos = jnp.arange(L, dtype=jnp.int32)
    rows = tpos // GRID_W
    cols = tpos % GRID_W
    alpha = (2.0 * DEPTH) ** 0.25
    sc = jax.nn.silu(c)
    scc = jax.nn.silu(c_ctx)
    xs, cs = x, ctx
    for l in range(DEPTH):
        last = l == DEPTH - 1
        mx = (sc @ w_ada[l] + b_ada[l])[:, None, :]
        mc = scc @ w_ada[l] + b_ada[l]
        x_sh1, x_sc1, x_g1, x_sh2, x_sc2, x_g2 = jnp.split(mx, N_MOD, axis=-1)
        c_sh1, c_sc1, c_g1, c_sh2, c_sc2, c_g2 = jnp.split(mc, N_MOD, axis=-1)
        hx = modulate(xs, x_sh1, x_sc1)
        hc = modulate(cs, c_sh1, c_sc1)
        aq, ak, av, bq, bk, bv, cq, ck, cv = split_proj(hx @ w_in[l])
        aqc, akc, avc, bqc, bkc, bvc, cqc, ckc, cvc = split_proj(hc @ w_in[l])
        aq = rope_2d(aq, rows, cols)
        ak = rope_2d(ak, rows, cols)
        bq = rope_2d(bq.reshape(B, L, 2 * B_HEADS, B_QK_DIM), rows, cols).reshape(B, L, B_HEADS, 2, B_QK_DIM)
        bk = rope_2d(bk.reshape(B, L, 2 * B_HEADS, B_QK_DIM), rows, cols).reshape(B, L, B_HEADS, 2, B_QK_DIM)
        lam_init = 0.8 - 0.6 * math.exp(-0.3 * l)
        lam = (jnp.exp(jnp.sum(lam_q1[l] * lam_k1[l]).astype(jnp.float32))
               - jnp.exp(jnp.sum(lam_q2[l] * lam_k2[l]).astype(jnp.float32)) + lam_init)
        ya = window_gqa(aq, ak, av, akc, avc, sink[l])
        yb = diff_attention_latent(bq, bk, bv, bkc, bvc, lam, subln_g[l], lam_init)
        yc = neighbourhood_attention(cq, ck, cv, ckc, cvc, na_bias[l])
        y = jnp.concatenate([ya, yb, yc], axis=-1).astype(xs.dtype) @ w_o[l]
        xn = post_norm(xs, y, x_g1, ln1_g[l], ln1_b[l], alpha)
        xn = post_norm(xn, swiglu(modulate(xn, x_sh2, x_sc2), w_ffn_in[l], w_ffn_out[l]), x_g2, ln2_g[l], ln2_b[l], alpha)
        if not last:
            yac = context_attention(aqc, akc, avc, sink[l])
            ybc = diff_head_norm(diff_core(bqc, bkc, bvc, lam), subln_g[l], lam_init)
            ycc = context_attention(cqc, ckc, cvc)
            yctx = jnp.concatenate([yac, ybc, ycc], axis=-1).astype(cs.dtype) @ w_o[l]
            cs = post_norm(cs, yctx, c_g1, ln1_g[l], ln1_b[l], alpha)
            cs = post_norm(cs, swiglu(modulate(cs, c_sh2, c_sc2), w_ffn_in[l], w_ffn_out[l]), c_g2, ln2_g[l], ln2_b[l], alpha)
        xs = xn
    return xs
```

```cpp
#include <hip/hip_runtime.h>
#include <hip/hip_bf16.h>
#include <cstdio>
#include <cstdint>
#include <cmath>
namespace pg8 {
#define PG8_LAS __attribute__((address_space(3)))
typedef unsigned short bf16_t;
typedef short bf16x8 __attribute__((ext_vector_type(8)));
typedef float f32x4 __attribute__((ext_vector_type(4)));
typedef unsigned u32x4 __attribute__((ext_vector_type(4)));
constexpr int BM = 256, BK = 64, HALF = 128, HTB = HALF * BK * 2  , STAGE_BYTES = 8 * HTB, NXCD = 8, WGM = 8;

__host__ __device__ __forceinline__ int lds_byte(int r, int c) { const int st = (r >> 4) * 2 + (c >> 5), rr = r & 15, cc = c & 31, ob = rr * 64 + cc * 2; return st * 1024 + (ob ^ (((ob >> 9) & 1) << 5)); }
__host__ __device__ __forceinline__ void stage_rc(int b, int& R, int& C) { const int st = b / 1024, sb = b % 1024, swz = sb ^ (((sb >> 9) & 1) << 5); R = (st >> 1) * 16 + swz / 64; C = (st & 1) * 32 + (swz % 64) / 2; }
__host__ __device__ __forceinline__ int perm32(int rho) { const int n = rho >> 4, i = rho & 15; return 8 * (i >> 2) + 4 * n + (i & 3); }

struct Unit { int pm, pn; };
struct Gemm { const bf16_t* A; const bf16_t* Bt; int M, N, K; };

struct StaticOrder {
    int nM, nN, nwg, G, c;
    __host__ __device__ void init(int M, int N, int G_, int c_) { nM = M / BM; nN = N / BM; nwg = nM * nN; G = G_; c = c_; }
    __host__ __device__ bool next(int i, Unit& u) const {
        const long L = (long)i * G + c; if (L >= nwg) return false;
        int wgid = (int)L; { const int q = nwg / NXCD, r = nwg % NXCD, xcd = wgid % NXCD, off = wgid / NXCD; wgid = (xcd < r ? xcd * (q + 1) : r * (q + 1) + (xcd - r) * q) + off; }
        const int nig = WGM * nN, gid = wgid / nig, fm = gid * WGM, gsz = (nM - fm) < WGM ? (nM - fm) : WGM;
        u.pm = fm + ((wgid % nig) % gsz); u.pn = (wgid % nig) / gsz; return true;
    }
    __device__ __forceinline__ void a_ready(const Unit&) const {}
    __device__ __forceinline__ void done(const Unit&) const {}
};

__device__ __forceinline__ unsigned cvt_pk_bf16(float lo, float hi) { unsigned r; asm volatile("v_cvt_pk_bf16_f32 %0, %1, %2" : "=v"(r) : "v"(lo), "v"(hi)); return r; }

struct EpiProj {
    static constexpr bool PERM = true, AFTER_DRAIN = false;
    bf16_t* O; int ldc; const float* cscale;
    __device__ __forceinline__ void operator()(const f32x4 (&acc)[2][2][4][2], const Unit& u, int wr, int wc, int fr, int fq) const {
        const int row0 = u.pm * BM + wr * 64 + fr; const int col0 = u.pn * BM + wc * 32 + 8 * fq;
        f32x4 sv[2][2];
#pragma unroll
        for (int bj = 0; bj < 2; ++bj)
#pragma unroll
            for (int n = 0; n < 2; ++n) sv[bj][n] = *(const f32x4*)(cscale + col0 + bj * HALF + 4 * n);
#pragma unroll
        for (int ai = 0; ai < 2; ++ai)
#pragma unroll
            for (int m = 0; m < 4; ++m) { bf16_t* rowp = O + (size_t)(row0 + ai * HALF + m * 16) * ldc + col0;
#pragma unroll
                for (int bj = 0; bj < 2; ++bj) { const f32x4 v0 = acc[ai][bj][m][0] * sv[bj][0], v1 = acc[ai][bj][m][1] * sv[bj][1];
                    u32x4 w; w.x = cvt_pk_bf16(v0[0], v0[1]); w.y = cvt_pk_bf16(v0[2], v0[3]); w.z = cvt_pk_bf16(v1[0], v1[1]); w.w = cvt_pk_bf16(v1[2], v1[3]);
                    *(u32x4*)(rowp + bj * HALF) = w; } }
    }
};
struct EpiRes {
    static constexpr bool PERM = false, AFTER_DRAIN = false;
    const float* res_lat; const float* res_ctx; float* out_lat; float* out_ctx; const float* mod  ; int gate_off; float alpha;
    __device__ __forceinline__ void operator()(const f32x4 (&acc)[2][2][4][2], const Unit& u, int wr, int wc, int fr, int fq) const {
        const int rowt = u.pm * BM; const bool isctx = rowt >= 16384;
        const float* rb = isctx ? res_ctx + (size_t)(rowt - 16384) * 1024 : res_lat + (size_t)rowt * 1024;
        float* ob = isctx ? out_ctx + (size_t)(rowt - 16384) * 1024 : out_lat + (size_t)rowt * 1024;
        const int bi = isctx ? 8 : (rowt >> 11);
        const int col0 = u.pn * BM + wc * 32 + 4 * fq;
        const float* gv = mod + bi * 6144 + gate_off + col0;
        f32x4 g[2][2];
#pragma unroll
        for (int bj = 0; bj < 2; ++bj)
#pragma unroll
            for (int n = 0; n < 2; ++n) g[bj][n] = *(const f32x4*)(gv + bj * HALF + n * 16);
#pragma unroll
        for (int ai = 0; ai < 2; ++ai)
#pragma unroll
            for (int m = 0; m < 4; ++m) { const size_t off = (size_t)(wr * 64 + fr + ai * HALF + m * 16) * 1024 + col0;
#pragma unroll
                for (int bj = 0; bj < 2; ++bj)
#pragma unroll
                    for (int n = 0; n < 2; ++n) { const f32x4 r = *(const f32x4*)(rb + off + bj * HALF + n * 16);
                        *(f32x4*)(ob + off + bj * HALF + n * 16) = r * alpha + g[bj][n] * acc[ai][bj][m][n]; }
                if (m & 1) asm volatile("" ::: "memory"); }
    }
};
__device__ __forceinline__ float silu_mul(float g, float u) { return g * u * __builtin_amdgcn_rcpf(1.0f + __builtin_amdgcn_exp2f(-1.4426950408889634f * g)); }
struct EpiSwiglu {
    static constexpr bool PERM = true, AFTER_DRAIN = false;
    bf16_t* O; int ldc;
    __device__ __forceinline__ void operator()(const f32x4 (&acc)[2][2][4][2], const Unit& u, int wr, int wc, int fr, int fq) const {
        const int row0 = u.pm * BM + wr * 64 + fr; const int col0 = u.pn * HALF + wc * 32 + 8 * fq;
#pragma unroll
        for (int ai = 0; ai < 2; ++ai)
#pragma unroll
            for (int m = 0; m < 4; ++m) { bf16_t* rowp = O + (size_t)(row0 + ai * HALF + m * 16) * ldc + col0;
                const f32x4 g0 = acc[ai][0][m][0], g1 = acc[ai][0][m][1], u0 = acc[ai][1][m][0], u1 = acc[ai][1][m][1];
                u32x4 w; w.x = cvt_pk_bf16(silu_mul(g0[0], u0[0]), silu_mul(g0[1], u0[1])); w.y = cvt_pk_bf16(silu_mul(g0[2], u0[2]), silu_mul(g0[3], u0[3]));
                w.z = cvt_pk_bf16(silu_mul(g1[0], u1[0]), silu_mul(g1[1], u1[1])); w.w = cvt_pk_bf16(silu_mul(g1[2], u1[2]), silu_mul(g1[3], u1[3]));
                *(u32x4*)rowp = w; }
    }
};

template <class Epi, class Sched, bool ALIGN_EPI = false, bool SP2 = false>
__device__ __forceinline__ void gemm_phase(PG8_LAS unsigned char* lds, const Gemm g, const Sched& S, const Epi& E) {
    int tid_ = threadIdx.x; asm volatile("" : "+v"(tid_) :: "memory"); const int tid = tid_, wid = __builtin_amdgcn_readfirstlane(tid >> 6), lane = tid & 63, wr = wid >> 2, wc = wid & 3, fr = lane & 15, fq = lane >> 4;
    const int K = g.K, nt = K / BK;
    unsigned voffA[2], voffB[2];
#pragma unroll
    for (int i = 0; i < 2; ++i) { int R, C; stage_rc(tid * 16 + i * 8192, R, C); const int Rb = Epi::PERM ? ((R & ~31) + perm32(R & 31)) : R;
        voffA[i] = (unsigned)(R * K + C) * 2u; voffB[i] = (unsigned)(Rb * K + C) * 2u; }
    const size_t kstep = (size_t)(BK * 2);
    const size_t hstep = (size_t)HALF * K * 2;
    const size_t tstep = 2 * hstep;
    const unsigned ldsw = (unsigned)wid * 1024u;
    const int aoff = lds_byte(wr * 64 + fr, fq * 8), boff = lds_byte(wc * 32 + fr, fq * 8);
#define PG8_SA(b, h) (((b) * 2 + (h)) * HTB)
#define PG8_SB(b, h) ((4 + (b) * 2 + (h)) * HTB)
#define PG8_STAGE(bufoff, gbase, voff) do { _Pragma("unroll") for (int _i = 0; _i < 2; ++_i) \
        __builtin_amdgcn_global_load_lds((const unsigned*)((const char*)(gbase) + (voff)[_i]), (PG8_LAS unsigned*)(lds + (bufoff) + ldsw + _i * 8192), 16, 0, 0); } while (0)
#define PG8_LDA(dst, b, h) do { _Pragma("unroll") for (int m = 0; m < 4; ++m) _Pragma("unroll") for (int k = 0; k < 2; ++k) dst[m][k] = *(const PG8_LAS bf16x8*)(lds + PG8_SA(b, h) + aoff + m * 2048 + k * 1024); } while (0)
#define PG8_LDB(dst, b, h) do { _Pragma("unroll") for (int n = 0; n < 2; ++n) _Pragma("unroll") for (int k = 0; k < 2; ++k) dst[n][k] = *(const PG8_LAS bf16x8*)(lds + PG8_SB(b, h) + boff + n * 2048 + k * 1024); } while (0)
#define PG8_MMA(ai, bj, At, Bt) do { __builtin_amdgcn_s_setprio(1); _Pragma("unroll") for (int m = 0; m < 4; ++m) _Pragma("unroll") for (int n = 0; n < 2; ++n) _Pragma("unroll") for (int k = 0; k < 2; ++k) \
        acc[ai][bj][m][n] = __builtin_amdgcn_mfma_f32_16x16x32_bf16(Bt[n][k], At[m][k], acc[ai][bj][m][n], 0, 0, 0); __builtin_amdgcn_s_setprio(0); } while (0)
#define PG8_WAIT_V(n) asm volatile("s_waitcnt vmcnt(" #n ")" ::: "memory")
#define PG8_WAIT_L(n) asm volatile("s_waitcnt lgkmcnt(" #n ")" ::: "memory")
#define PG8_BAR __builtin_amdgcn_s_barrier()
#define PG8_SCHED __builtin_amdgcn_sched_barrier(0)
    Unit cur, nxt; int ui = 0;
    if (!S.next(0, cur)) return;
    f32x4 acc[2][2][4][2];
#pragma unroll
    for (int a = 0; a < 2; ++a)
#pragma unroll
        for (int b = 0; b < 2; ++b)
#pragma unroll
            for (int m = 0; m < 4; ++m)
#pragma unroll
                for (int n = 0; n < 2; ++n) acc[a][b][m][n] = (f32x4){0.f, 0.f, 0.f, 0.f};
    bf16x8 At[4][2], B0[2][2], B1[2][2];
    const char* cA = (const char*)g.A + (size_t)cur.pm * tstep; const char* cB = (const char*)g.Bt + (size_t)cur.pn * tstep;
    S.a_ready(cur);
    if constexpr (SP2) {
        PG8_STAGE(PG8_SB(0, 0), cB, voffB); PG8_STAGE(PG8_SB(0, 1), cB + hstep, voffB); PG8_STAGE(PG8_SA(0, 0), cA, voffA); PG8_STAGE(PG8_SA(0, 1), cA + hstep, voffA);
        if (wr == 1) PG8_BAR;
        PG8_WAIT_V(2); PG8_BAR;
        PG8_STAGE(PG8_SB(1, 0), cB + kstep, voffB); PG8_STAGE(PG8_SA(1, 0), cA + kstep, voffA); PG8_STAGE(PG8_SB(1, 1), cB + hstep + kstep, voffB);
        PG8_WAIT_V(6); PG8_BAR;
    } else {
        PG8_STAGE(PG8_SB(0, 0), cB, voffB); PG8_STAGE(PG8_SA(0, 0), cA, voffA); PG8_STAGE(PG8_SB(0, 1), cB + hstep, voffB); PG8_STAGE(PG8_SA(0, 1), cA + hstep, voffA);
        if (wr == 1) PG8_BAR;
        PG8_WAIT_V(4); PG8_BAR;
        PG8_STAGE(PG8_SB(1, 0), cB + kstep, voffB); PG8_STAGE(PG8_SA(1, 0), cA + kstep, voffA); PG8_STAGE(PG8_SB(1, 1), cB + hstep + kstep, voffB);
        PG8_WAIT_V(6); PG8_BAR;
    }
    for (;;) {
        const bool has_next = S.next(ui + 1, nxt);
        const char* nA = has_next ? (const char*)g.A + (size_t)nxt.pm * tstep : cA; const char* nB = has_next ? (const char*)g.Bt + (size_t)nxt.pn * tstep : cB;
        for (int t = 0; t < nt; t += 2) {
            const bool last = (t == nt - 2);
            const char* a1 = cA + (size_t)(t + 1) * kstep;
            const char* a2 = last ? nA : cA + (size_t)(t + 2) * kstep; const char* b2 = last ? nB : cB + (size_t)(t + 2) * kstep;
            const char* a3 = a2 + kstep; const char* b3 = b2 + kstep;
            if (last && has_next) S.a_ready(nxt);
            if constexpr (SP2) {
            PG8_LDB(B0, 0, 0); PG8_LDB(B1, 0, 1); PG8_SCHED; PG8_LDA(At, 0, 0); PG8_STAGE(PG8_SA(1, 1), a1 + hstep, voffA);
            PG8_WAIT_V(8); PG8_WAIT_L(0); PG8_BAR; PG8_MMA(0, 0, At, B0); PG8_MMA(0, 1, At, B1); PG8_BAR; PG8_SCHED;
            PG8_LDA(At, 0, 1); PG8_STAGE(PG8_SB(0, 0), b2, voffB); PG8_STAGE(PG8_SB(0, 1), b2 + hstep, voffB); PG8_STAGE(PG8_SA(0, 0), a2, voffA);
            PG8_WAIT_V(8); PG8_WAIT_L(0); PG8_BAR; PG8_MMA(1, 0, At, B0); PG8_MMA(1, 1, At, B1); PG8_BAR; PG8_SCHED;
            PG8_LDB(B0, 1, 0); PG8_LDB(B1, 1, 1); PG8_SCHED; PG8_LDA(At, 1, 0); PG8_STAGE(PG8_SA(0, 1), a2 + hstep, voffA);
            PG8_WAIT_V(8); PG8_WAIT_L(0); PG8_BAR; PG8_MMA(0, 0, At, B0); PG8_MMA(0, 1, At, B1); PG8_BAR; PG8_SCHED;
            PG8_LDA(At, 1, 1); PG8_STAGE(PG8_SB(1, 0), b3, voffB); PG8_STAGE(PG8_SB(1, 1), b3 + hstep, voffB); PG8_STAGE(PG8_SA(1, 0), a3, voffA);
            PG8_WAIT_V(8); PG8_WAIT_L(0); PG8_BAR; PG8_MMA(1, 0, At, B0); PG8_MMA(1, 1, At, B1); PG8_BAR; PG8_SCHED;
            } else {
            PG8_LDB(B0, 0, 0); PG8_SCHED; PG8_LDA(At, 0, 0); PG8_STAGE(PG8_SA(1, 1), a1 + hstep, voffA);
            PG8_WAIT_L(8); PG8_BAR; PG8_WAIT_L(0); PG8_MMA(0, 0, At, B0); PG8_BAR; PG8_SCHED;
            PG8_LDB(B1, 0, 1); PG8_STAGE(PG8_SB(0, 0), b2, voffB);
            PG8_BAR; PG8_WAIT_L(0); PG8_MMA(0, 1, At, B1); PG8_BAR;
            PG8_LDA(At, 0, 1); PG8_STAGE(PG8_SA(0, 0), a2, voffA);
            PG8_BAR; PG8_WAIT_L(0); PG8_MMA(1, 0, At, B0); PG8_BAR; PG8_SCHED;
            PG8_STAGE(PG8_SB(0, 1), b2 + hstep, voffB);
            PG8_WAIT_V(6); PG8_BAR; PG8_MMA(1, 1, At, B1); PG8_BAR;
            PG8_LDB(B0, 1, 0); PG8_SCHED; PG8_LDA(At, 1, 0); PG8_STAGE(PG8_SA(0, 1), a2 + hstep, voffA);
            PG8_WAIT_L(8); PG8_BAR; PG8_WAIT_L(0); PG8_MMA(0, 0, At, B0); PG8_BAR; PG8_SCHED;
            PG8_LDB(B1, 1, 1); PG8_STAGE(PG8_SB(1, 0), b3, voffB);
            PG8_BAR; PG8_WAIT_L(0); PG8_MMA(0, 1, At, B1); PG8_BAR;
            PG8_LDA(At, 1, 1); PG8_STAGE(PG8_SA(1, 0), a3, voffA);
            PG8_BAR; PG8_WAIT_L(0); PG8_MMA(1, 0, At, B0); PG8_BAR; PG8_SCHED;
            PG8_STAGE(PG8_SB(1, 1), b3 + hstep, voffB);
            PG8_WAIT_V(6); PG8_BAR; PG8_MMA(1, 1, At, B1); PG8_BAR;
            }
        }
        if constexpr (ALIGN_EPI) { if (wr == 0) PG8_BAR; }
        if constexpr (!Epi::AFTER_DRAIN) { E(acc, cur, wr, wc, fr, fq); S.done(cur); }
        if (!has_next) break;
#pragma unroll
        for (int a = 0; a < 2; ++a)
#pragma unroll
            for (int b = 0; b < 2; ++b)
#pragma unroll
                for (int m = 0; m < 4; ++m)
#pragma unroll
                    for (int n = 0; n < 2; ++n) acc[a][b][m][n] = (f32x4){0.f, 0.f, 0.f, 0.f};
        cur = nxt; cA = nA; cB = nB; ++ui;
        if constexpr (ALIGN_EPI) { if (wr == 1) PG8_BAR; }
    }
    PG8_WAIT_V(0);
    if constexpr (!ALIGN_EPI) { if (wr == 0) PG8_BAR; }
    PG8_BAR;
    if constexpr (Epi::AFTER_DRAIN) { E.fused(acc, cur, wr, wc, fr, fq, lds, wid, lane); S.done(cur); }
#undef PG8_SA
#undef PG8_SB
#undef PG8_STAGE
#undef PG8_LDA
#undef PG8_LDB
#undef PG8_MMA
#undef PG8_WAIT_V
#undef PG8_WAIT_L
#undef PG8_BAR
#undef PG8_SCHED
}
}
#ifndef PG8_SP2
#define PG8_SP2 true
#endif
#ifndef PG8_ALIGN
#define PG8_ALIGN true
#endif
constexpr int NWAVES = 8;
constexpr int D = 1024, NB = 8, SEQ = 2048, CTXL = 256, DEPTH = 2, GW = 64;
constexpr int MLAT = NB * SEQ, MCTX = NB * CTXL, MALL = MLAT + MCTX;
constexpr int PW = 2560, FF = 2816, NMOD = 6 * D;
constexpr int C_AQ = 0, C_AK = 384, C_AV = 512, C_BQ = 640, C_BK = 896, C_BV = 1152, C_CQ = 1408, C_CK = 1792, C_CV = 2176;
constexpr int M_A = 0, M_B = 384, M_C = 640;
constexpr float LN_EPS = 1e-5f, LOG2E = 1.4426950408889634f, ALPHA = 1.4142135623730951f;
enum { I_X = 0, I_C, I_CTX, I_CCTX, I_WADA, I_BADA, I_WIN, I_WO, I_SINK, I_LQ1, I_LK1, I_LQ2, I_LK2, I_SUBG, I_NAB, I_LN1G, I_LN1B, I_WFI, I_WFO, I_LN2G, I_LN2B, N_IN };
constexpr size_t MiB = 1u << 20;
constexpr size_t WS_CTL = 0, CTL_ZERO_BYTES = 1 * MiB;
constexpr size_t WS_MOD = 1 * MiB;
constexpr size_t WS_TAB = WS_MOD + 512 * 1024;
constexpr size_t TAB_ROPEA = 0, TAB_ROPEB = 2048, TAB_SCAL = 3072, TAB_CSCALE = 3136;
constexpr size_t WS_W = 2 * MiB;
constexpr size_t W_LAYER = 23 * MiB + 512 * 1024, W_IN = 0, W_O = 5 * MiB, W_FI = 7 * MiB, W_FO = 18 * MiB;
constexpr size_t WS_HA = 49 * MiB;
constexpr size_t WS_RC = 85 * MiB;
constexpr size_t WS_OB = 93 * MiB;
constexpr size_t WS_P = 111 * MiB;
constexpr size_t WS_MIX = 201 * MiB;
constexpr size_t WS_HID = 111 * MiB;
constexpr size_t WS_END = 237 * MiB;
static_assert(WS_W + 2 * W_LAYER <= WS_HA && WS_HA + (size_t)MALL * D * 2 <= WS_RC && WS_RC + (size_t)MCTX * D * 4 <= WS_OB && WS_OB + (size_t)MALL * 512 * 2 <= WS_P && WS_P + (size_t)MALL * PW * 2 <= WS_MIX && WS_MIX + (size_t)MALL * D * 2 <= WS_END && WS_HID + (size_t)MALL * FF * 2 <= WS_END, "d_ws map");
constexpr int CW_TMO = 0, CW_CODE = 1, CW_BAR = 4096;
constexpr int RING_OFF = 0, RING_BYTES = 131072;
constexpr int LDSCTL_OFF = RING_BYTES, MISC_OFF = LDSCTL_OFF + 320;
constexpr int LDS_BYTES = 147456;
static_assert(MISC_OFF + 128 <= LDS_BYTES, "LDS map");

#define GAS __attribute__((address_space(1)))
#define LAS __attribute__((address_space(3)))
typedef unsigned short bf16;
typedef unsigned v4u __attribute__((ext_vector_type(4)));
typedef float f32x4 __attribute__((ext_vector_type(4)));
typedef short bf16x8 __attribute__((ext_vector_type(8)));
typedef GAS unsigned gu32;
typedef GAS unsigned long long gu64;
#define RLX_AGENT __ATOMIC_RELAXED, __HIP_MEMORY_SCOPE_AGENT
#define LDS_WAIT() asm volatile("s_waitcnt lgkmcnt(0)" ::: "memory")
#define VM_WAIT() asm volatile("s_waitcnt vmcnt(0)" ::: "memory")
__device__ __forceinline__ unsigned long long rt() { return __builtin_amdgcn_s_memrealtime(); }
__device__ __forceinline__ unsigned f2bf(float f) { unsigned u = __builtin_bit_cast(unsigned, f); return (u + 0x7fffu + ((u >> 16) & 1u)) >> 16; }
__device__ __forceinline__ unsigned pk2(float lo, float hi) { return f2bf(lo) | (f2bf(hi) << 16); }

#define XB_TMO      128
#define XB_XCNT(j)  (256  + 64 * (j))
#define XB_XSUB(j)  (1280 + 64 * (j))
#define XB_XGEN(j)  (2304 + 64 * (j))
#define XB_TOP      3328
#define XB_TOPGEN   3392
#define XCD_BAR_WORDS 3456
#define XB_SPIN_CAP (1u << 18)

__device__ __forceinline__ unsigned xb_ld(unsigned* p)              { return __hip_atomic_load(p, __ATOMIC_RELAXED, __HIP_MEMORY_SCOPE_AGENT); }
__device__ __forceinline__ unsigned xb_add(unsigned* p, unsigned v) { return __hip_atomic_fetch_add(p, v, __ATOMIC_RELAXED, __HIP_MEMORY_SCOPE_AGENT); }
__device__ __forceinline__ unsigned xb_xcc_id() { return (unsigned)__builtin_amdgcn_s_getreg((3 << 11) | 20) & 0xFu; }
#define XB_SPIN(cond, bar) do { unsigned _sp = 0; while (cond) { __builtin_amdgcn_s_sleep(1); \
    if ((++_sp & 255u) == 0u) { if (xb_ld(&(bar)[XB_TMO])) break; if (_sp > XB_SPIN_CAP) { atomicAdd(&(bar)[XB_TMO], 1u); break; } } } } while (0)

struct XcdBarrier {
    unsigned* bar; unsigned x;
    volatile LAS unsigned* st;
};

__device__ __forceinline__ XcdBarrier xcd_barrier_post(unsigned* bar, volatile LAS unsigned* st) {
    XcdBarrier b; b.bar = bar; b.x = xb_xcc_id(); b.st = st;
    if (threadIdx.x == 0) (void)xb_add(&bar[XB_XCNT(b.x)], 1u);
    return b;
}
__device__ __forceinline__ void xcd_barrier_complete(unsigned* bar, unsigned x, unsigned& nloc, unsigned& nx) {
    const unsigned G = gridDim.x * gridDim.y * gridDim.z;
    unsigned sum, cnt, mine, sp = 0u;
    for (;;) {
        sum = 0u; cnt = 0u; mine = 0u;
#pragma unroll
        for (unsigned j = 0; j < 16; ++j) { const unsigned c = xb_ld(&bar[XB_XCNT(j)]); sum += c; cnt += (c > 0u) ? 1u : 0u; mine = (j == x) ? c : mine; }
        if (sum == G) break;
        __builtin_amdgcn_s_sleep(1);
        if ((++sp & 255u) == 0u) { if (xb_ld(&bar[XB_TMO])) break; if (sp > XB_SPIN_CAP) { atomicAdd(&bar[XB_TMO], 1u); break; } }
    }
    nloc = mine > 0u ? mine : 1u; nx = cnt > 0u ? cnt : 1u;
}

__device__ __forceinline__ void xcd_barrier(const XcdBarrier& b) {
    asm volatile("s_waitcnt vmcnt(0)" ::: "memory");
    __syncthreads();
    if (threadIdx.x == 0) {
        unsigned* bar = b.bar;
        __builtin_amdgcn_s_waitcnt(0);
        unsigned nloc = b.st[0], nx = b.st[1];
        if (nloc == 0u) { xcd_barrier_complete(bar, b.x, nloc, nx); b.st[0] = nloc; b.st[1] = nx; }
        const unsigned old = xb_add(&bar[XB_XSUB(b.x)], 1u);
        const unsigned gen = old / nloc;
        if (old + 1u == (gen + 1u) * nloc) {
            __builtin_amdgcn_fence(__ATOMIC_RELEASE, "agent");
            asm volatile("s_waitcnt vmcnt(0)" ::: "memory");
            const unsigned og = xb_add(&bar[XB_TOP], 1u);
            const unsigned tg = og / nx;
            if (og + 1u == (tg + 1u) * nx) xb_add(&bar[XB_TOPGEN], 1u);
            else XB_SPIN(xb_ld(&bar[XB_TOPGEN]) == tg, bar);
            __builtin_amdgcn_fence(__ATOMIC_ACQUIRE, "agent");
            xb_add(&bar[XB_XGEN(b.x)], 1u);
            asm volatile("s_waitcnt vmcnt(0)" ::: "memory");
        } else {
            XB_SPIN(xb_ld(&bar[XB_XGEN(b.x)]) == gen, bar);
            __builtin_amdgcn_fence(__ATOMIC_ACQUIRE, "agent");
            asm volatile("s_waitcnt vmcnt(0)" ::: "memory");
        }
    }
    __syncthreads();
}

struct Frame {
    LAS unsigned char* lds;
    volatile LAS unsigned* MISC;
    gu32* ctl;
    int tid, lane, wave;
    int vcu, G;
    const float* in[N_IN]; float* out; unsigned char* ws;
};
__device__ __forceinline__ float bf2f(unsigned short u) { return __uint_as_float((unsigned)u << 16); }
__device__ __forceinline__ float wave_sum(float v) {
#pragma unroll
    for (int o = 1; o < 64; o <<= 1) v += __shfl_xor(v, o);
    return v;
}
__device__ __forceinline__ float wave_max(float v) {
#pragma unroll
    for (int o = 1; o < 64; o <<= 1) v = fmaxf(v, __shfl_xor(v, o));
    return v;
}
template <int MODE>
__device__ __forceinline__ void p0_transpose_item(const float* W, int K, int N, bf16* WT, LAS float* scr, int item, int lane) {
    const int nblk = N / 32, kb = item / nblk, nb = item % nblk, k0 = 64 * kb, n0 = 32 * nb;
#pragma unroll 8
    for (int i = 0; i < 32; ++i) { const int kk = 2 * i + (lane >> 5); scr[kk * 33 + (lane & 31)] = W[(size_t)(k0 + kk) * N + n0 + (lane & 31)]; }
    LDS_WAIT(); asm volatile("" ::: "memory");
    const int c = lane & 7;
    int r0 = n0;
    if (MODE == 1) { const int bj = n0 / FF, rem = n0 - bj * FF; r0 = 256 * (rem >> 7) + 128 * bj + (rem & 127); }
#pragma unroll
    for (int j = 0; j < 4; ++j) { const int n = (lane >> 3) + 8 * j; const LAS float* s = scr + (8 * c) * 33 + n;
        v4u o; o.x = pk2(s[0 * 33], s[1 * 33]); o.y = pk2(s[2 * 33], s[3 * 33]); o.z = pk2(s[4 * 33], s[5 * 33]); o.w = pk2(s[6 * 33], s[7 * 33]);
        *(GAS v4u*)(WT + (size_t)(r0 + n) * K + k0 + 8 * c) = o; }
    LDS_WAIT(); asm volatile("" ::: "memory");
}
__device__ __forceinline__ float silu_f(float x) { return x / (1.0f + expf(-x)); }

__device__ __forceinline__ void p0a_prologue(Frame& F) {
    int tid_ = F.tid; asm volatile("" : "+v"(tid_) :: "memory"); const int P_tid = tid_, P_lane = tid_ & 63, P_wave = __builtin_amdgcn_readfirstlane(tid_ >> 6); (void)P_tid; (void)P_lane; (void)P_wave;

    float* MOD = (float*)(F.ws + WS_MOD); float* TAB = (float*)(F.ws + WS_TAB);
    {
        LAS float* sv = (LAS float*)(F.lds);
        LAS float* red = (LAS float*)(F.lds + 9 * 1024 * 4);
        for (int i = P_tid; i < 9 * 1024; i += NWAVES * 64) { const int bi = i >> 10, k = i & 1023; const float v = bi < 8 ? F.in[I_C][bi * 1024 + k] : F.in[I_CCTX][k]; sv[i] = silu_f(v); }
        __syncthreads();
        for (int it = F.vcu; it < 2 * 96; it += F.G) {
            const int l = it / 96, n0 = (it % 96) * 64;
            const float* W = F.in[I_WADA] + (size_t)l * D * NMOD + n0 + P_lane;
            float acc[9];
#pragma unroll
            for (int b = 0; b < 9; ++b) acc[b] = 0.f;
            const int kbeg = P_wave * 128;
#pragma unroll 8
            for (int k = kbeg; k < kbeg + 128; ++k) { const float w = W[(size_t)k * NMOD];
#pragma unroll
                for (int b = 0; b < 9; ++b) acc[b] += sv[b * 1024 + k] * w; }
#pragma unroll
            for (int b = 0; b < 9; ++b) red[(P_wave * 9 + b) * 64 + P_lane] = acc[b];
            __syncthreads();
            for (int i = P_tid; i < 9 * 64; i += NWAVES * 64) { const int b = i >> 6, n = i & 63; float s = 0.f;
#pragma unroll
                for (int w = 0; w < 8; ++w) s += red[(w * 9 + b) * 64 + n];
                MOD[((size_t)l * 9 + b) * NMOD + n0 + n] = s + F.in[I_BADA][l * NMOD + n0 + n]; }
            __syncthreads();
        }
    }
    if (F.vcu == F.G - 1) {
        for (int i = P_tid; i < 64 * 16; i += NWAVES * 64) { const int pos = i >> 4, f = i & 15; const float ang = (float)pos * exp2f(-(float)f * (13.287712379549449f / 16.0f)); TAB[TAB_ROPEA + 2 * i] = cosf(ang); TAB[TAB_ROPEA + 2 * i + 1] = sinf(ang); }
        for (int i = P_tid; i < 64 * 8; i += NWAVES * 64) { const int pos = i >> 3, f = i & 7; const float ang = (float)pos * exp2f(-(float)f * (13.287712379549449f / 8.0f)); TAB[TAB_ROPEB + 2 * i] = cosf(ang); TAB[TAB_ROPEB + 2 * i + 1] = sinf(ang); }
        if (P_wave == 0) {
            for (int l = 0; l < DEPTH; ++l) {
                float a = P_lane < 32 ? F.in[I_LQ1][l * 32 + P_lane] * F.in[I_LK1][l * 32 + P_lane] : 0.f;
                float b = P_lane < 32 ? F.in[I_LQ2][l * 32 + P_lane] * F.in[I_LK2][l * 32 + P_lane] : 0.f;
                a = wave_sum(a); b = wave_sum(b);
                const float lam_init = 0.8f - 0.6f * expf(-0.3f * (float)l);
                if (P_lane == 0) { TAB[TAB_SCAL + 4 * l] = expf(a) - expf(b) + lam_init; TAB[TAB_SCAL + 4 * l + 1] = 1.0f - lam_init; }
            }
        }
        for (int c = P_tid; c < PW; c += NWAVES * 64) {
            float s = 1.0f;
            if (c < C_AK || (c >= C_CQ && c < C_CK)) s = 0.125f * LOG2E;
            else if (c >= C_BQ && c < C_BK) s = 0.17677669529663687f * LOG2E;
            TAB[TAB_CSCALE + c] = s;
        }
    }
    __syncthreads();
    LAS float* scr = (LAS float*)(F.lds + RING_OFF + P_wave * 16384);
    const int gw = F.vcu * NWAVES + P_wave, NGW = F.G * NWAVES;
    constexpr int I_1 = (D / 64) * (PW / 32), I_2 = (D / 64) * (D / 32), I_3 = (D / 64) * (2 * FF / 32), I_4 = (FF / 64) * (D / 32), I_L = I_1 + I_2 + I_3 + I_4;
    for (int it = gw; it < DEPTH * I_L; it += NGW) {
        const int l = it / I_L; int r = it % I_L;
        unsigned char* wl = F.ws + WS_W + (size_t)l * W_LAYER;
        if (r < I_1) { p0_transpose_item<0>(F.in[I_WIN] + (size_t)l * D * PW, D, PW, (bf16*)(wl + W_IN), scr, r, P_lane); continue; } r -= I_1;
        if (r < I_2) { p0_transpose_item<0>(F.in[I_WO] + (size_t)l * D * D, D, D, (bf16*)(wl + W_O), scr, r, P_lane); continue; } r -= I_2;
        if (r < I_3) { p0_transpose_item<1>(F.in[I_WFI] + (size_t)l * D * 2 * FF, D, 2 * FF, (bf16*)(wl + W_FI), scr, r, P_lane); continue; } r -= I_3;
        p0_transpose_item<0>(F.in[I_WFO] + (size_t)l * FF * D, FF, D, (bf16*)(wl + W_FO), scr, r, P_lane);
    }
}
__device__ __forceinline__ float* res_row(Frame& F, int r) { return r < MLAT ? F.out + (size_t)r * D : (float*)(F.ws + WS_RC) + (size_t)(r - MLAT) * D; }
__device__ __forceinline__ const float* in_row(Frame& F, int r) { return r < MLAT ? F.in[I_X] + (size_t)r * D : F.in[I_CTX] + (size_t)(r - MLAT) * D; }
__device__ __forceinline__ int row_bi(int r) { return r < MLAT ? (r >> 11) : 8; }
__device__ __forceinline__ void p0b_modulate(Frame& F) {
    int tid_ = F.tid; asm volatile("" : "+v"(tid_) :: "memory"); const int P_tid = tid_, P_lane = tid_ & 63, P_wave = __builtin_amdgcn_readfirstlane(tid_ >> 6); (void)P_tid; (void)P_lane; (void)P_wave;

    const float* MOD = (const float*)(F.ws + WS_MOD); bf16* HA = (bf16*)(F.ws + WS_HA);
    const int gw = F.vcu * NWAVES + P_wave, NGW = F.G * NWAVES;
    for (int r = gw; r < MALL; r += NGW) {
        const GAS f32x4* xr = (const GAS f32x4*)in_row(F, r) + P_lane; const float* md = MOD + (size_t)row_bi(r) * NMOD;
        GAS unsigned long long* o8 = (GAS unsigned long long*)(HA + (size_t)r * D) + P_lane;
#pragma unroll
        for (int j = 0; j < 4; ++j) { const f32x4 v = xr[64 * j]; const int c = 4 * P_lane + 256 * j; const f32x4 sh = *(const f32x4*)(md + c), sc = *(const f32x4*)(md + D + c);
            const f32x4 h = v * (sc + 1.0f) + sh; o8[64 * j] = (unsigned long long)pk2(h.x, h.y) | ((unsigned long long)pk2(h.z, h.w) << 32); }
    }
}
__device__ __forceinline__ void ln_pass(Frame& F, int nrows, const float* lng, const float* lnb, const float* mod  , int sh_off) {
    int tid_ = F.tid; asm volatile("" : "+v"(tid_) :: "memory"); const int P_tid = tid_, P_lane = tid_ & 63, P_wave = __builtin_amdgcn_readfirstlane(tid_ >> 6); (void)P_tid; (void)P_lane; (void)P_wave;

    bf16* HA = (bf16*)(F.ws + WS_HA);
    const int gw = F.vcu * NWAVES + P_wave, NGW = F.G * NWAVES;
    for (int r = gw; r < nrows; r += NGW) {
        float* rr = res_row(F, r); GAS f32x4* xr = (GAS f32x4*)rr + P_lane;
        f32x4 v[4]; float s = 0.f;
#pragma unroll
        for (int j = 0; j < 4; ++j) { v[j] = xr[64 * j]; s += (v[j].x + v[j].y) + (v[j].z + v[j].w); }
        const float mean = wave_sum(s) * (1.f / D); float s2 = 0.f;
#pragma unroll
        for (int j = 0; j < 4; ++j) { v[j] = v[j] - mean; s2 += (v[j].x * v[j].x + v[j].y * v[j].y) + (v[j].z * v[j].z + v[j].w * v[j].w); }
        const float rstd = 1.f / sqrtf(wave_sum(s2) * (1.f / D) + LN_EPS);
        const float* md = mod ? mod + (size_t)row_bi(r) * NMOD + sh_off : nullptr;
        GAS unsigned long long* o8 = (GAS unsigned long long*)(HA + (size_t)r * D) + P_lane;
#pragma unroll
        for (int j = 0; j < 4; ++j) { const int c = 4 * P_lane + 256 * j; const f32x4 g = *(const f32x4*)(lng + c), b = *(const f32x4*)(lnb + c);
            const f32x4 y = v[j] * rstd * g + b; xr[64 * j] = y;
            if (md) { const f32x4 sh = *(const f32x4*)(md + c), sc = *(const f32x4*)(md + D + c); const f32x4 h = y * (sc + 1.0f) + sh;
                o8[64 * j] = (unsigned long long)pk2(h.x, h.y) | ((unsigned long long)pk2(h.z, h.w) << 32); } }
    }
}
__device__ __forceinline__ void rope_pass(Frame& F) {
    int tid_ = F.tid; asm volatile("" : "+v"(tid_) :: "memory"); const int P_tid = tid_, P_lane = tid_ & 63, P_wave = __builtin_amdgcn_readfirstlane(tid_ >> 6); (void)P_tid; (void)P_lane; (void)P_wave;

    bf16* P = (bf16*)(F.ws + WS_P); const float* TAB = (const float*)(F.ws + WS_TAB);
    const int gt = F.vcu * NWAVES * 64 + P_tid, NT = F.G * NWAVES * 64;
    for (long idx = gt; idx < (long)MLAT * 512; idx += NT) {
        const int r = (int)(idx >> 9), p = (int)(idx & 511); const int t = r & (SEQ - 1), prow = t >> 6, pcol = t & 63;
        int c1, c2, pos, fi; bool isA;
        if (p < 256) { const int h = p >> 5, q = p & 31; const int hb = (h < 6 ? C_AQ + h * 64 : C_AK + (h - 6) * 64); isA = true;
            if (q < 16) { c1 = hb + q; c2 = hb + 16 + q; pos = prow; fi = q; } else { c1 = hb + 32 + (q - 16); c2 = hb + 48 + (q - 16); pos = pcol; fi = q - 16; } }
        else { const int pp = p - 256, v = pp >> 4, q = pp & 15; const int vb = (v < 8 ? C_BQ + v * 32 : C_BK + (v - 8) * 32); isA = false;
            if (q < 8) { c1 = vb + q; c2 = vb + 8 + q; pos = prow; fi = q; } else { c1 = vb + 16 + (q - 8); c2 = vb + 24 + (q - 8); pos = pcol; fi = q - 8; } }
        const float cs = isA ? TAB[TAB_ROPEA + 2 * (pos * 16 + fi)] : TAB[TAB_ROPEB + 2 * (pos * 8 + fi)];
        const float sn = isA ? TAB[TAB_ROPEA + 2 * (pos * 16 + fi) + 1] : TAB[TAB_ROPEB + 2 * (pos * 8 + fi) + 1];
        bf16* row = P + (size_t)r * PW; const float x1 = bf2f(row[c1]), x2 = bf2f(row[c2]);
        row[c1] = (bf16)f2bf(x1 * cs - x2 * sn); row[c2] = (bf16)f2bf(x2 * cs + x1 * sn);
    }
}

namespace naive {
constexpr int MAXK = 2304;
__device__ __forceinline__ void load64(const bf16* p, float* v) {
#pragma unroll
    for (int i = 0; i < 8; ++i) { const v4u w = *(const v4u*)(p + 8 * i);
        v[8 * i + 0] = __uint_as_float(w.x << 16); v[8 * i + 1] = __uint_as_float(w.x & 0xffff0000u); v[8 * i + 2] = __uint_as_float(w.y << 16); v[8 * i + 3] = __uint_as_float(w.y & 0xffff0000u);
        v[8 * i + 4] = __uint_as_float(w.z << 16); v[8 * i + 5] = __uint_as_float(w.z & 0xffff0000u); v[8 * i + 6] = __uint_as_float(w.w << 16); v[8 * i + 7] = __uint_as_float(w.w & 0xffff0000u); }
}
template <int VAR> __global__ void __launch_bounds__(128) attn(const bf16* __restrict__ P, bf16* __restrict__ MIX, const float* __restrict__ sinkv, const float* __restrict__ nab, const float* __restrict__ scal, const float* __restrict__ subg) {
    __shared__ float sc[2][2][MAXK];
    constexpr bool LAT = (VAR % 2) == 0; constexpr int KIND = VAR / 2; constexpr int NH = (KIND == 1) ? 4 : 6;
    const int lane = threadIdx.x & 63, wv = threadIdx.x >> 6;
    const int item = blockIdx.x * 2 + wv; const int nrows = LAT ? MLAT : MCTX;
    if (item >= nrows * NH) return;
    const int ri = item / NH, h = item % NH;
    const int row = LAT ? ri : MLAT + ri; const int b = LAT ? (ri >> 11) : (ri >> 8); const int t = ri & (SEQ - 1);
    const int qcol = KIND == 0 ? C_AQ + h * 64 : (KIND == 1 ? C_BQ + h * 64 : C_CQ + h * 64);
    const int kcol = KIND == 0 ? C_AK + (h / 3) * 64 : (KIND == 1 ? C_BK + h * 64 : C_CK + h * 64);
    const int vcol = KIND == 0 ? C_AV + (h / 3) * 64 : (KIND == 1 ? C_BV + h * 64 : C_CV + h * 64);
    float q[64]; load64(P + (size_t)row * PW + qcol, q);
    int nloc = 0, lo = 0, rs = 0, cs = 0; const int qr = t >> 6, qw = t & 63;
    if (LAT) {
        if (KIND == 0) { lo = max(0, t - 128); const int hi = min(SEQ - 1, t + 128); nloc = hi - lo + 1; }
        else if (KIND == 1) { nloc = SEQ; }
        else { rs = min(max(qr - 4, 0), 24); cs = min(max(qw - 8, 0), 48); nloc = 128; }
    }
    const int nk = nloc + CTXL;
    float* s1 = sc[wv][0]; float* s2 = sc[wv][1];
    float m1 = -INFINITY, m2 = -INFINITY;
    for (int j = lane; j < nk; j += 64) {
        int krow; float bias = 0.f;
        if (j < nloc) {
            int tk;
            if (KIND == 0) tk = lo + j; else if (KIND == 1) tk = j; else { const int kr = rs + (j >> 4), kc = cs + (j & 15); tk = kr * 64 + kc;
                const int dr = kr - qr + 7, dc = min(max(kc - qw, -15), 15) + 15; bias = nab[(h * 15 + dr) * 31 + dc] * LOG2E; }
            krow = b * SEQ + tk;
        } else krow = MLAT + b * CTXL + (j - nloc);
        float kv[64]; load64(P + (size_t)krow * PW + kcol, kv);
        if (KIND == 1) { float d1 = 0.f, d2 = 0.f;
#pragma unroll
            for (int d = 0; d < 32; ++d) { d1 += q[d] * kv[d]; d2 += q[32 + d] * kv[32 + d]; }
            s1[j] = d1; s2[j] = d2; m1 = fmaxf(m1, d1); m2 = fmaxf(m2, d2);
        } else { float d1 = 0.f;
#pragma unroll
            for (int d = 0; d < 64; ++d) d1 += q[d] * kv[d];
            d1 += bias; s1[j] = d1; m1 = fmaxf(m1, d1); }
    }
    float sk = -INFINITY; if (KIND == 0) { sk = sinkv[h] * LOG2E; m1 = fmaxf(m1, sk); }
    m1 = wave_max(m1); if (KIND == 1) m2 = wave_max(m2);
    float l1 = 0.f, l2 = 0.f;
    for (int j = lane; j < nk; j += 64) { const float p = exp2f(s1[j] - m1); s1[j] = p; l1 += p; if (KIND == 1) { const float p2 = exp2f(s2[j] - m2); s2[j] = p2; l2 += p2; } }
    l1 = wave_sum(l1); if (KIND == 1) l2 = wave_sum(l2); if (KIND == 0) l1 += exp2f(sk - m1);
    __builtin_amdgcn_s_waitcnt(0xC07F); asm volatile("" ::: "memory");
    const float lam = (KIND == 1) ? scal[0] : 0.f;
    const float i1 = 1.0f / l1, i2 = (KIND == 1) ? lam / l2 : 0.f;
    float o = 0.f;
    for (int j = 0; j < nk; ++j) {
        int krow;
        if (j < nloc) { int tk; if (KIND == 0) tk = lo + j; else if (KIND == 1) tk = j; else tk = (rs + (j >> 4)) * 64 + cs + (j & 15); krow = b * SEQ + tk; }
        else krow = MLAT + b * CTXL + (j - nloc);
        const float w = (KIND == 1) ? (s1[j] * i1 - s2[j] * i2) : s1[j] * i1;
        o += w * bf2f(P[(size_t)krow * PW + vcol + lane]);
    }
    if (KIND == 1) { const float ms = wave_sum(o * o) * (1.0f / 64.0f); o = o * (1.0f / sqrtf(ms + LN_EPS)) * subg[lane] * scal[1]; }
    const int mcol = KIND == 0 ? M_A + h * 64 : (KIND == 1 ? M_B + h * 64 : M_C + h * 64);
    MIX[(size_t)row * D + mcol + lane] = (bf16)f2bf(o);
}
}

constexpr int PH_P0A = 0, PH_P0B = 1, PH_L0 = 2, PH_PER_LAYER = 8, PH_END = PH_L0 + DEPTH * PH_PER_LAYER;
struct Args { const float* in[N_IN]; float* out; unsigned char* ws; int ph_lo, ph_hi; };
__global__ void __launch_bounds__(NWAVES * 64, 2) skel_fwd(Args args) {
    extern __shared__ __attribute__((aligned(16))) unsigned char lds[];
    Frame F;
    F.lds = (LAS unsigned char*)lds;
    F.MISC = (volatile LAS unsigned*)(F.lds + MISC_OFF);
    F.tid = threadIdx.x; F.lane = F.tid & 63; F.wave = __builtin_amdgcn_readfirstlane(F.tid >> 6);
    F.G = gridDim.x; { const int bx = blockIdx.x; F.vcu = (F.G % 8 == 0) ? (bx % 8) * (F.G / 8) + bx / 8 : bx; }
    F.ws = args.ws; F.out = args.out; F.ctl = (gu32*)(args.ws + WS_CTL);
#pragma unroll
    for (int i = 0; i < N_IN; ++i) F.in[i] = args.in[i];
    for (int u = F.tid; u < (LDS_BYTES - LDSCTL_OFF) / 4; u += NWAVES * 64) ((LAS unsigned*)(F.lds + LDSCTL_OFF))[u] = 0u;
    __syncthreads();
    const int lo = args.ph_lo, hi = args.ph_hi;
    const bool multi = (hi - lo) > 1;
    XcdBarrier bar; bar.bar = (unsigned*)(F.ctl + CW_BAR); bar.x = 0; bar.st = nullptr;
    if (multi) bar = xcd_barrier_post((unsigned*)(F.ctl + CW_BAR), F.MISC + 8);
#define IN(k) (lo <= (k) && (k) < hi)
#define SEAM(k) do { if (IN(k) && IN((k) + 1)) xcd_barrier(bar); } while (0)
    const float* MOD = (const float*)(F.ws + WS_MOD); const float* TAB = (const float*)(F.ws + WS_TAB);
    bf16* HA = (bf16*)(F.ws + WS_HA); bf16* P = (bf16*)(F.ws + WS_P); bf16* MIX = (bf16*)(F.ws + WS_MIX); bf16* HID = (bf16*)(F.ws + WS_HID);
    float* RC = (float*)(F.ws + WS_RC);

    if (IN(PH_P0A)) { p0a_prologue(F); } SEAM(PH_P0A);
    if (IN(PH_P0B)) { p0b_modulate(F); } SEAM(PH_P0B);
#pragma unroll 1
    for (int l = 0; l < DEPTH; ++l) {
        const int pb = PH_L0 + l * PH_PER_LAYER; const bool last = (l == DEPTH - 1);
        const unsigned char* wl = F.ws + WS_W + (size_t)l * W_LAYER; const float* modl = MOD + (size_t)l * 9 * NMOD;
        const int Mrest = last ? MLAT : MALL;
        if (IN(pb + 0)) {
            pg8::Gemm g{HA, (const bf16*)(wl + W_IN), MALL, PW, D}; pg8::StaticOrder S; S.init(MALL, PW, F.G, (int)blockIdx.x);
            pg8::EpiProj E{P, PW, TAB + TAB_CSCALE};
            pg8::gemm_phase<pg8::EpiProj, pg8::StaticOrder, PG8_ALIGN, PG8_SP2>(F.lds + RING_OFF, g, S, E);
        } SEAM(pb + 0);
        if (IN(pb + 1)) { rope_pass(F); } SEAM(pb + 1);
        if (IN(pb + 2)) {   } SEAM(pb + 2);
        if (IN(pb + 3)) {
            pg8::Gemm g{MIX, (const bf16*)(wl + W_O), Mrest, D, D}; pg8::StaticOrder S; S.init(Mrest, D, F.G, (int)blockIdx.x);
            pg8::EpiRes E{l == 0 ? F.in[I_X] : F.out, l == 0 ? F.in[I_CTX] : RC, F.out, RC, modl, 2 * D, ALPHA};
            pg8::gemm_phase<pg8::EpiRes, pg8::StaticOrder, PG8_ALIGN, PG8_SP2>(F.lds + RING_OFF, g, S, E);
        } SEAM(pb + 3);
        if (IN(pb + 4)) { ln_pass(F, Mrest, F.in[I_LN1G] + l * D, F.in[I_LN1B] + l * D, modl, 3 * D); } SEAM(pb + 4);
        if (IN(pb + 5)) {
            pg8::Gemm g{HA, (const bf16*)(wl + W_FI), Mrest, 2 * FF, D}; pg8::StaticOrder S; S.init(Mrest, 2 * FF, F.G, (int)blockIdx.x);
            pg8::EpiSwiglu E{HID, FF};
            pg8::gemm_phase<pg8::EpiSwiglu, pg8::StaticOrder, PG8_ALIGN, PG8_SP2>(F.lds + RING_OFF, g, S, E);
        } SEAM(pb + 5);
        if (IN(pb + 6)) {
            pg8::Gemm g{HID, (const bf16*)(wl + W_FO), Mrest, D, FF}; pg8::StaticOrder S; S.init(Mrest, D, F.G, (int)blockIdx.x);
            pg8::EpiRes E{F.out, RC, F.out, RC, modl, 5 * D, ALPHA};
            pg8::gemm_phase<pg8::EpiRes, pg8::StaticOrder, PG8_ALIGN, PG8_SP2>(F.lds + RING_OFF, g, S, E);
        } SEAM(pb + 6);
        if (IN(pb + 7)) { ln_pass(F, Mrest, F.in[I_LN2G] + l * D, F.in[I_LN2B] + l * D, last ? nullptr : modl + 9 * NMOD, 0); } SEAM(pb + 7);
    }
#undef IN
#undef SEAM
}

extern "C" void kernel_launch(void* const* d_in, const int* in_sizes, int n_in, void* d_out, int out_size, void* d_ws, size_t ws_size, hipStream_t stream) {
    static int grid = 0;
    if (grid == 0) {
        if (n_in != N_IN || in_sizes[0] != MLAT * D || out_size != MLAT * D || ws_size < WS_END) { fprintf(stderr, "kernel_launch: unexpected shapes (n_in %d, in0 %d, out %d, ws %zu); nothing launched\n", n_in, n_in > 0 ? in_sizes[0] : -1, out_size, ws_size); grid = -1; return; }
        int dev = 0, cus = 0, per_cu = 0;
        if (hipGetDevice(&dev) != hipSuccess || hipDeviceGetAttribute(&cus, hipDeviceAttributeMultiprocessorCount, dev) != hipSuccess) { grid = -1; return; }
        if (hipFuncSetAttribute((const void*)skel_fwd, hipFuncAttributeMaxDynamicSharedMemorySize, LDS_BYTES) != hipSuccess) { fprintf(stderr, "kernel_launch: hipFuncSetAttribute failed\n"); grid = -1; return; }
        if (hipOccupancyMaxActiveBlocksPerMultiprocessor(&per_cu, (const void*)skel_fwd, NWAVES * 64, LDS_BYTES) != hipSuccess || per_cu < 1) { fprintf(stderr, "kernel_launch: occupancy query reports %d\n", per_cu); per_cu = 1; }
        (void)hipGetLastError();
        grid = cus;
    }
    if (grid < 0) return;
    (void)hipMemsetAsync((char*)d_ws + WS_CTL, 0, CTL_ZERO_BYTES, stream);
    Args a{};
    for (int i = 0; i < N_IN; ++i) a.in[i] = (const float*)d_in[i];
    a.out = (float*)d_out; a.ws = (unsigned char*)d_ws;
    const bf16* P = (const bf16*)((unsigned char*)d_ws + WS_P); bf16* MIX = (bf16*)((unsigned char*)d_ws + WS_MIX);
    const float* TAB = (const float*)((unsigned char*)d_ws + WS_TAB);
    for (int ph = 0; ph < PH_END; ++ph) {
        const int l = (ph - PH_L0) / PH_PER_LAYER, off = (ph - PH_L0) % PH_PER_LAYER;
        if (ph >= PH_L0 && off == 2) {
            const float* sink = (const float*)d_in[I_SINK] + l * 6; const float* nab = (const float*)d_in[I_NAB] + l * 6 * 15 * 31; const float* subg = (const float*)d_in[I_SUBG] + l * 64;
            const float* scal = TAB + TAB_SCAL + 4 * l;
            naive::attn<0><<<MLAT * 6 / 2, 128, 0, stream>>>(P, MIX, sink, nab, scal, subg);
            naive::attn<2><<<MLAT * 4 / 2, 128, 0, stream>>>(P, MIX, sink, nab, scal, subg);
            naive::attn<4><<<MLAT * 6 / 2, 128, 0, stream>>>(P, MIX, sink, nab, scal, subg);
            if (l == 0) {
                naive::attn<1><<<MCTX * 6 / 2, 128, 0, stream>>>(P, MIX, sink, nab, scal, subg);
                naive::attn<3><<<MCTX * 4 / 2, 128, 0, stream>>>(P, MIX, sink, nab, scal, subg);
                naive::attn<5><<<MCTX * 6 / 2, 128, 0, stream>>>(P, MIX, sink, nab, scal, subg);
            }
            continue;
        }
        a.ph_lo = ph; a.ph_hi = ph + 1;
        hipLaunchKernelGGL(skel_fwd, dim3(grid), dim3(NWAVES * 64), LDS_BYTES, stream, a);
    }
}
```

```cpp
#include <hip/hip_runtime.h>
#include <hip/hip_bf16.h>
#include <cstdio>
#include <cstdint>
#include <cmath>
namespace pg8 {
#define PG8_LAS __attribute__((address_space(3)))
typedef unsigned short bf16_t;
typedef short bf16x8 __attribute__((ext_vector_type(8)));
typedef float f32x4 __attribute__((ext_vector_type(4)));
typedef unsigned u32x4 __attribute__((ext_vector_type(4)));
constexpr int BM = 256, BK = 64, HALF = 128, HTB = HALF * BK * 2  , STAGE_BYTES = 8 * HTB, NXCD = 8, WGM = 8;

__host__ __device__ __forceinline__ int lds_byte(int r, int c) { const int st = (r >> 4) * 2 + (c >> 5), rr = r & 15, cc = c & 31, ob = rr * 64 + cc * 2; return st * 1024 + (ob ^ (((ob >> 9) & 1) << 5)); }
__host__ __device__ __forceinline__ void stage_rc(int b, int& R, int& C) { const int st = b / 1024, sb = b % 1024, swz = sb ^ (((sb >> 9) & 1) << 5); R = (st >> 1) * 16 + swz / 64; C = (st & 1) * 32 + (swz % 64) / 2; }
__host__ __device__ __forceinline__ int perm32(int rho) { const int n = rho >> 4, i = rho & 15; return 8 * (i >> 2) + 4 * n + (i & 3); }

struct Unit { int pm, pn; };
struct Gemm { const bf16_t* A; const bf16_t* Bt; int M, N, K; };

struct StaticOrder {
    int nM, nN, nwg, G, c;
    __host__ __device__ void init(int M, int N, int G_, int c_) { nM = M / BM; nN = N / BM; nwg = nM * nN; G = G_; c = c_; }
    __host__ __device__ bool next(int i, Unit& u) const {
        const long L = (long)i * G + c; if (L >= nwg) return false;
        int wgid = (int)L; { const int q = nwg / NXCD, r = nwg % NXCD, xcd = wgid % NXCD, off = wgid / NXCD; wgid = (xcd < r ? xcd * (q + 1) : r * (q + 1) + (xcd - r) * q) + off; }
        const int nig = WGM * nN, gid = wgid / nig, fm = gid * WGM, gsz = (nM - fm) < WGM ? (nM - fm) : WGM;
        u.pm = fm + ((wgid % nig) % gsz); u.pn = (wgid % nig) / gsz; return true;
    }
    __device__ __forceinline__ void a_ready(const Unit&) const {}
    __device__ __forceinline__ void done(const Unit&) const {}
};

__device__ __forceinline__ unsigned cvt_pk_bf16(float lo, float hi) { unsigned r; asm volatile("v_cvt_pk_bf16_f32 %0, %1, %2" : "=v"(r) : "v"(lo), "v"(hi)); return r; }

struct EpiProj {
    static constexpr bool PERM = true, AFTER_DRAIN = false;
    bf16_t* O; int ldc; const float* cscale;
    __device__ __forceinline__ void operator()(const f32x4 (&acc)[2][2][4][2], const Unit& u, int wr, int wc, int fr, int fq) const {
        const int row0 = u.pm * BM + wr * 64 + fr; const int col0 = u.pn * BM + wc * 32 + 8 * fq;
        f32x4 sv[2][2];
#pragma unroll
        for (int bj = 0; bj < 2; ++bj)
#pragma unroll
            for (int n = 0; n < 2; ++n) sv[bj][n] = *(const f32x4*)(cscale + col0 + bj * HALF + 4 * n);
#pragma unroll
        for (int ai = 0; ai < 2; ++ai)
#pragma unroll
            for (int m = 0; m < 4; ++m) { bf16_t* rowp = O + (size_t)(row0 + ai * HALF + m * 16) * ldc + col0;
#pragma unroll
                for (int bj = 0; bj < 2; ++bj) { const f32x4 v0 = acc[ai][bj][m][0] * sv[bj][0], v1 = acc[ai][bj][m][1] * sv[bj][1];
                    u32x4 w; w.x = cvt_pk_bf16(v0[0], v0[1]); w.y = cvt_pk_bf16(v0[2], v0[3]); w.z = cvt_pk_bf16(v1[0], v1[1]); w.w = cvt_pk_bf16(v1[2], v1[3]);
                    *(u32x4*)(rowp + bj * HALF) = w; } }
    }
};
struct EpiRes {
    static constexpr bool PERM = false, AFTER_DRAIN = false;
    const float* res_lat; const float* res_ctx; float* out_lat; float* out_ctx; const float* mod  ; int gate_off; float alpha;
    __device__ __forceinline__ void operator()(const f32x4 (&acc)[2][2][4][2], const Unit& u, int wr, int wc, int fr, int fq) const {
        const int rowt = u.pm * BM; const bool isctx = rowt >= 16384;
        const float* rb = isctx ? res_ctx + (size_t)(rowt - 16384) * 1024 : res_lat + (size_t)rowt * 1024;
        float* ob = isctx ? out_ctx + (size_t)(rowt - 16384) * 1024 : out_lat + (size_t)rowt * 1024;
        const int bi = isctx ? 8 : (rowt >> 11);
        const int col0 = u.pn * BM + wc * 32 + 4 * fq;
        const float* gv = mod + bi * 6144 + gate_off + col0;
        f32x4 g[2][2];
#pragma unroll
        for (int bj = 0; bj < 2; ++bj)
#pragma unroll
            for (int n = 0; n < 2; ++n) g[bj][n] = *(const f32x4*)(gv + bj * HALF + n * 16);
#pragma unroll
        for (int ai = 0; ai < 2; ++ai)
#pragma unroll
            for (int m = 0; m < 4; ++m) { const size_t off = (size_t)(wr * 64 + fr + ai * HALF + m * 16) * 1024 + col0;
#pragma unroll
                for (int bj = 0; bj < 2; ++bj)
#pragma unroll
                    for (int n = 0; n < 2; ++n) { const f32x4 r = *(const f32x4*)(rb + off + bj * HALF + n * 16);
                        *(f32x4*)(ob + off + bj * HALF + n * 16) = r * alpha + g[bj][n] * acc[ai][bj][m][n]; }
                if (m & 1) asm volatile("" ::: "memory"); }
    }
};
__device__ __forceinline__ float silu_mul(float g, float u) { return g * u * __builtin_amdgcn_rcpf(1.0f + __builtin_amdgcn_exp2f(-1.4426950408889634f * g)); }
struct EpiSwiglu {
    static constexpr bool PERM = true, AFTER_DRAIN = false;
    bf16_t* O; int ldc;
    __device__ __forceinline__ void operator()(const f32x4 (&acc)[2][2][4][2], const Unit& u, int wr, int wc, int fr, int fq) const {
        const int row0 = u.pm * BM + wr * 64 + fr; const int col0 = u.pn * HALF + wc * 32 + 8 * fq;
#pragma unroll
        for (int ai = 0; ai < 2; ++ai)
#pragma unroll
            for (int m = 0; m < 4; ++m) { bf16_t* rowp = O + (size_t)(row0 + ai * HALF + m * 16) * ldc + col0;
                const f32x4 g0 = acc[ai][0][m][0], g1 = acc[ai][0][m][1], u0 = acc[ai][1][m][0], u1 = acc[ai][1][m][1];
                u32x4 w; w.x = cvt_pk_bf16(silu_mul(g0[0], u0[0]), silu_mul(g0[1], u0[1])); w.y = cvt_pk_bf16(silu_mul(g0[2], u0[2]), silu_mul(g0[3], u0[3]));
                w.z = cvt_pk_bf16(silu_mul(g1[0], u1[0]), silu_mul(g1[1], u1[1])); w.w = cvt_pk_bf16(silu_mul(g1[2], u1[2]), silu_mul(g1[3], u1[3]));
                *(u32x4*)rowp = w; }
    }
};

template <class Epi, class Sched, bool ALIGN_EPI = false, bool SP2 = false>
__device__ __forceinline__ void gemm_phase(PG8_LAS unsigned char* lds, const Gemm g, const Sched& S, const Epi& E) {
    int tid_ = threadIdx.x; asm volatile("" : "+v"(tid_) :: "memory"); const int tid = tid_, wid = __builtin_amdgcn_readfirstlane(tid >> 6), lane = tid & 63, wr = wid >> 2, wc = wid & 3, fr = lane & 15, fq = lane >> 4;
    const int K = g.K, nt = K / BK;
    unsigned voffA[2], voffB[2];
#pragma unroll
    for (int i = 0; i < 2; ++i) { int R, C; stage_rc(tid * 16 + i * 8192, R, C); const int Rb = Epi::PERM ? ((R & ~31) + perm32(R & 31)) : R;
        voffA[i] = (unsigned)(R * K + C) * 2u; voffB[i] = (unsigned)(Rb * K + C) * 2u; }
    const size_t kstep = (size_t)(BK * 2);
    const size_t hstep = (size_t)HALF * K * 2;
    const size_t tstep = 2 * hstep;
    const unsigned ldsw = (unsigned)wid * 1024u;
    const int aoff = lds_byte(wr * 64 + fr, fq * 8), boff = lds_byte(wc * 32 + fr, fq * 8);
#define PG8_SA(b, h) (((b) * 2 + (h)) * HTB)
#define PG8_SB(b, h) ((4 + (b) * 2 + (h)) * HTB)
#define PG8_STAGE(bufoff, gbase, voff) do { _Pragma("unroll") for (int _i = 0; _i < 2; ++_i) \
        __builtin_amdgcn_global_load_lds((const unsigned*)((const char*)(gbase) + (voff)[_i]), (PG8_LAS unsigned*)(lds + (bufoff) + ldsw + _i * 8192), 16, 0, 0); } while (0)
#define PG8_LDA(dst, b, h) do { _Pragma("unroll") for (int m = 0; m < 4; ++m) _Pragma("unroll") for (int k = 0; k < 2; ++k) dst[m][k] = *(const PG8_LAS bf16x8*)(lds + PG8_SA(b, h) + aoff + m * 2048 + k * 1024); } while (0)
#define PG8_LDB(dst, b, h) do { _Pragma("unroll") for (int n = 0; n < 2; ++n) _Pragma("unroll") for (int k = 0; k < 2; ++k) dst[n][k] = *(const PG8_LAS bf16x8*)(lds + PG8_SB(b, h) + boff + n * 2048 + k * 1024); } while (0)
#define PG8_MMA(ai, bj, At, Bt) do { __builtin_amdgcn_s_setprio(1); _Pragma("unroll") for (int m = 0; m < 4; ++m) _Pragma("unroll") for (int n = 0; n < 2; ++n) _Pragma("unroll") for (int k = 0; k < 2; ++k) \
        acc[ai][bj][m][n] = __builtin_amdgcn_mfma_f32_16x16x32_bf16(Bt[n][k], At[m][k], acc[ai][bj][m][n], 0, 0, 0); __builtin_amdgcn_s_setprio(0); } while (0)
#define PG8_WAIT_V(n) asm volatile("s_waitcnt vmcnt(" #n ")" ::: "memory")
#define PG8_WAIT_L(n) asm volatile("s_waitcnt lgkmcnt(" #n ")" ::: "memory")
#define PG8_BAR __builtin_amdgcn_s_barrier()
#define PG8_SCHED __builtin_amdgcn_sched_barrier(0)
    Unit cur, nxt; int ui = 0;
    if (!S.next(0, cur)) return;
    f32x4 acc[2][2][4][2];
#pragma unroll
    for (int a = 0; a < 2; ++a)
#pragma unroll
        for (int b = 0; b < 2; ++b)
#pragma unroll
            for (int m = 0; m < 4; ++m)
#pragma unroll
                for (int n = 0; n < 2; ++n) acc[a][b][m][n] = (f32x4){0.f, 0.f, 0.f, 0.f};
    bf16x8 At[4][2], B0[2][2], B1[2][2];
    const char* cA = (const char*)g.A + (size_t)cur.pm * tstep; const char* cB = (const char*)g.Bt + (size_t)cur.pn * tstep;
    S.a_ready(cur);
    if constexpr (SP2) {
        PG8_STAGE(PG8_SB(0, 0), cB, voffB); PG8_STAGE(PG8_SB(0, 1), cB + hstep, voffB); PG8_STAGE(PG8_SA(0, 0), cA, voffA); PG8_STAGE(PG8_SA(0, 1), cA + hstep, voffA);
        if (wr == 1) PG8_BAR;
        PG8_WAIT_V(2); PG8_BAR;
        PG8_STAGE(PG8_SB(1, 0), cB + kstep, voffB); PG8_STAGE(PG8_SA(1, 0), cA + kstep, voffA); PG8_STAGE(PG8_SB(1, 1), cB + hstep + kstep, voffB);
        PG8_WAIT_V(6); PG8_BAR;
    } else {
        PG8_STAGE(PG8_SB(0, 0), cB, voffB); PG8_STAGE(PG8_SA(0, 0), cA, voffA); PG8_STAGE(PG8_SB(0, 1), cB + hstep, voffB); PG8_STAGE(PG8_SA(0, 1), cA + hstep, voffA);
        if (wr == 1) PG8_BAR;
        PG8_WAIT_V(4); PG8_BAR;
        PG8_STAGE(PG8_SB(1, 0), cB + kstep, voffB); PG8_STAGE(PG8_SA(1, 0), cA + kstep, voffA); PG8_STAGE(PG8_SB(1, 1), cB + hstep + kstep, voffB);
        PG8_WAIT_V(6); PG8_BAR;
    }
    for (;;) {
        const bool has_next = S.next(ui + 1, nxt);
        const char* nA = has_next ? (const char*)g.A + (size_t)nxt.pm * tstep : cA; const char* nB = has_next ? (const char*)g.Bt + (size_t)nxt.pn * tstep : cB;
        for (int t = 0; t < nt; t += 2) {
            const bool last = (t == nt - 2);
            const char* a1 = cA + (size_t)(t + 1) * kstep;
            const char* a2 = last ? nA : cA + (size_t)(t + 2) * kstep; const char* b2 = last ? nB : cB + (size_t)(t + 2) * kstep;
            const char* a3 = a2 + kstep; const char* b3 = b2 + kstep;
            if (last && has_next) S.a_ready(nxt);
            if constexpr (SP2) {
            PG8_LDB(B0, 0, 0); PG8_LDB(B1, 0, 1); PG8_SCHED; PG8_LDA(At, 0, 0); PG8_STAGE(PG8_SA(1, 1), a1 + hstep, voffA);
            PG8_WAIT_V(8); PG8_WAIT_L(0); PG8_BAR; PG8_MMA(0, 0, At, B0); PG8_MMA(0, 1, At, B1); PG8_BAR; PG8_SCHED;
            PG8_LDA(At, 0, 1); PG8_STAGE(PG8_SB(0, 0), b2, voffB); PG8_STAGE(PG8_SB(0, 1), b2 + hstep, voffB); PG8_STAGE(PG8_SA(0, 0), a2, voffA);
            PG8_WAIT_V(8); PG8_WAIT_L(0); PG8_BAR; PG8_MMA(1, 0, At, B0); PG8_MMA(1, 1, At, B1); PG8_BAR; PG8_SCHED;
            PG8_LDB(B0, 1, 0); PG8_LDB(B1, 1, 1); PG8_SCHED; PG8_LDA(At, 1, 0); PG8_STAGE(PG8_SA(0, 1), a2 + hstep, voffA);
            PG8_WAIT_V(8); PG8_WAIT_L(0); PG8_BAR; PG8_MMA(0, 0, At, B0); PG8_MMA(0, 1, At, B1); PG8_BAR; PG8_SCHED;
            PG8_LDA(At, 1, 1); PG8_STAGE(PG8_SB(1, 0), b3, voffB); PG8_STAGE(PG8_SB(1, 1), b3 + hstep, voffB); PG8_STAGE(PG8_SA(1, 0), a3, voffA);
            PG8_WAIT_V(8); PG8_WAIT_L(0); PG8_BAR; PG8_MMA(1, 0, At, B0); PG8_MMA(1, 1, At, B1); PG8_BAR; PG8_SCHED;
            } else {
            PG8_LDB(B0, 0, 0); PG8_SCHED; PG8_LDA(At, 0, 0); PG8_STAGE(PG8_SA(1, 1), a1 + hstep, voffA);
            PG8_WAIT_L(8); PG8_BAR; PG8_WAIT_L(0); PG8_MMA(0, 0, At, B0); PG8_BAR; PG8_SCHED;
            PG8_LDB(B1, 0, 1); PG8_STAGE(PG8_SB(0, 0), b2, voffB);
            PG8_BAR; PG8_WAIT_L(0); PG8_MMA(0, 1, At, B1); PG8_BAR;
            PG8_LDA(At, 0, 1); PG8_STAGE(PG8_SA(0, 0), a2, voffA);
            PG8_BAR; PG8_WAIT_L(0); PG8_MMA(1, 0, At, B0); PG8_BAR; PG8_SCHED;
            PG8_STAGE(PG8_SB(0, 1), b2 + hstep, voffB);
            PG8_WAIT_V(6); PG8_BAR; PG8_MMA(1, 1, At, B1); PG8_BAR;
            PG8_LDB(B0, 1, 0); PG8_SCHED; PG8_LDA(At, 1, 0); PG8_STAGE(PG8_SA(0, 1), a2 + hstep, voffA);
            PG8_WAIT_L(8); PG8_BAR; PG8_WAIT_L(0); PG8_MMA(0, 0, At, B0); PG8_BAR; PG8_SCHED;
            PG8_LDB(B1, 1, 1); PG8_STAGE(PG8_SB(1, 0), b3, voffB);
            PG8_BAR; PG8_WAIT_L(0); PG8_MMA(0, 1, At, B1); PG8_BAR;
            PG8_LDA(At, 1, 1); PG8_STAGE(PG8_SA(1, 0), a3, voffA);
            PG8_BAR; PG8_WAIT_L(0); PG8_MMA(1, 0, At, B0); PG8_BAR; PG8_SCHED;
            PG8_STAGE(PG8_SB(1, 1), b3 + hstep, voffB);
            PG8_WAIT_V(6); PG8_BAR; PG8_MMA(1, 1, At, B1); PG8_BAR;
            }
        }
        if constexpr (ALIGN_EPI) { if (wr == 0) PG8_BAR; }
        if constexpr (!Epi::AFTER_DRAIN) { E(acc, cur, wr, wc, fr, fq); S.done(cur); }
        if (!has_next) break;
#pragma unroll
        for (int a = 0; a < 2; ++a)
#pragma unroll
            for (int b = 0; b < 2; ++b)
#pragma unroll
                for (int m = 0; m < 4; ++m)
#pragma unroll
                    for (int n = 0; n < 2; ++n) acc[a][b][m][n] = (f32x4){0.f, 0.f, 0.f, 0.f};
        cur = nxt; cA = nA; cB = nB; ++ui;
        if constexpr (ALIGN_EPI) { if (wr == 1) PG8_BAR; }
    }
    PG8_WAIT_V(0);
    if constexpr (!ALIGN_EPI) { if (wr == 0) PG8_BAR; }
    PG8_BAR;
    if constexpr (Epi::AFTER_DRAIN) { E.fused(acc, cur, wr, wc, fr, fq, lds, wid, lane); S.done(cur); }
#undef PG8_SA
#undef PG8_SB
#undef PG8_STAGE
#undef PG8_LDA
#undef PG8_LDB
#undef PG8_MMA
#undef PG8_WAIT_V
#undef PG8_WAIT_L
#undef PG8_BAR
#undef PG8_SCHED
}
}
#ifndef PG8_SP2
#define PG8_SP2 true
#endif
#ifndef PG8_ALIGN
#define PG8_ALIGN true
#endif
constexpr int NWAVES = 8;
constexpr int D = 1024, NB = 8, SEQ = 2048, CTXL = 256, DEPTH = 2, GW = 64;
constexpr int MLAT = NB * SEQ, MCTX = NB * CTXL, MALL = MLAT + MCTX;
constexpr int PW = 2560, FF = 2816, NMOD = 6 * D;
constexpr int C_AQ = 0, C_AK = 384, C_AV = 512, C_BQ = 640, C_BK = 896, C_BV = 1152, C_CQ = 1408, C_CK = 1792, C_CV = 2176;
constexpr int M_A = 0, M_B = 384, M_C = 640;
constexpr float LN_EPS = 1e-5f, LOG2E = 1.4426950408889634f, ALPHA = 1.4142135623730951f;
enum { I_X = 0, I_C, I_CTX, I_CCTX, I_WADA, I_BADA, I_WIN, I_WO, I_SINK, I_LQ1, I_LK1, I_LQ2, I_LK2, I_SUBG, I_NAB, I_LN1G, I_LN1B, I_WFI, I_WFO, I_LN2G, I_LN2B, N_IN };
constexpr size_t MiB = 1u << 20;
constexpr size_t WS_CTL = 0, CTL_ZERO_BYTES = 1 * MiB;
constexpr size_t WS_MOD = 1 * MiB;
constexpr size_t WS_TAB = WS_MOD + 512 * 1024;
constexpr size_t TAB_ROPEA = 0, TAB_ROPEB = 2048, TAB_SCAL = 3072, TAB_CSCALE = 3136;
constexpr size_t WS_W = 2 * MiB;
constexpr size_t W_LAYER = 23 * MiB + 512 * 1024, W_IN = 0, W_O = 5 * MiB, W_FI = 7 * MiB, W_FO = 18 * MiB;
constexpr size_t WS_HA = 49 * MiB;
constexpr size_t WS_RC = 85 * MiB;
constexpr size_t WS_OB = 93 * MiB;
constexpr size_t WS_P = 111 * MiB;
constexpr size_t WS_MIX = 201 * MiB;
constexpr size_t WS_HID = 111 * MiB;
constexpr size_t WS_END = 237 * MiB;
static_assert(WS_W + 2 * W_LAYER <= WS_HA && WS_HA + (size_t)MALL * D * 2 <= WS_RC && WS_RC + (size_t)MCTX * D * 4 <= WS_OB && WS_OB + (size_t)MALL * 512 * 2 <= WS_P && WS_P + (size_t)MALL * PW * 2 <= WS_MIX && WS_MIX + (size_t)MALL * D * 2 <= WS_END && WS_HID + (size_t)MALL * FF * 2 <= WS_END, "d_ws map");
constexpr int CW_TMO = 0, CW_CODE = 1, CW_BAR = 4096;
constexpr int RING_OFF = 0, RING_BYTES = 131072;
constexpr int LDSCTL_OFF = RING_BYTES, MISC_OFF = LDSCTL_OFF + 320;
constexpr int LDS_BYTES = 147456;
static_assert(MISC_OFF + 128 <= LDS_BYTES, "LDS map");

#define GAS __attribute__((address_space(1)))
#define LAS __attribute__((address_space(3)))
typedef unsigned short bf16;
typedef unsigned v4u __attribute__((ext_vector_type(4)));
typedef float f32x4 __attribute__((ext_vector_type(4)));
typedef short bf16x8 __attribute__((ext_vector_type(8)));
typedef GAS unsigned gu32;
typedef GAS unsigned long long gu64;
#define RLX_AGENT __ATOMIC_RELAXED, __HIP_MEMORY_SCOPE_AGENT
#define LDS_WAIT() asm volatile("s_waitcnt lgkmcnt(0)" ::: "memory")
#define VM_WAIT() asm volatile("s_waitcnt vmcnt(0)" ::: "memory")
__device__ __forceinline__ unsigned long long rt() { return __builtin_amdgcn_s_memrealtime(); }
__device__ __forceinline__ unsigned f2bf(float f) { unsigned u = __builtin_bit_cast(unsigned, f); return (u + 0x7fffu + ((u >> 16) & 1u)) >> 16; }
__device__ __forceinline__ unsigned pk2(float lo, float hi) { return f2bf(lo) | (f2bf(hi) << 16); }

#define XB_TMO      128
#define XB_XCNT(j)  (256  + 64 * (j))
#define XB_XSUB(j)  (1280 + 64 * (j))
#define XB_XGEN(j)  (2304 + 64 * (j))
#define XB_TOP      3328
#define XB_TOPGEN   3392
#define XCD_BAR_WORDS 3456
#define XB_SPIN_CAP (1u << 18)

__device__ __forceinline__ unsigned xb_ld(unsigned* p)              { return __hip_atomic_load(p, __ATOMIC_RELAXED, __HIP_MEMORY_SCOPE_AGENT); }
__device__ __forceinline__ unsigned xb_add(unsigned* p, unsigned v) { return __hip_atomic_fetch_add(p, v, __ATOMIC_RELAXED, __HIP_MEMORY_SCOPE_AGENT); }
__device__ __forceinline__ unsigned xb_xcc_id() { return (unsigned)__builtin_amdgcn_s_getreg((3 << 11) | 20) & 0xFu; }
#define XB_SPIN(cond, bar) do { unsigned _sp = 0; while (cond) { __builtin_amdgcn_s_sleep(1); \
    if ((++_sp & 255u) == 0u) { if (xb_ld(&(bar)[XB_TMO])) break; if (_sp > XB_SPIN_CAP) { atomicAdd(&(bar)[XB_TMO], 1u); break; } } } } while (0)

struct XcdBarrier {
    unsigned* bar; unsigned x;
    volatile LAS unsigned* st;
};

__device__ __forceinline__ XcdBarrier xcd_barrier_post(unsigned* bar, volatile LAS unsigned* st) {
    XcdBarrier b; b.bar = bar; b.x = xb_xcc_id(); b.st = st;
    if (threadIdx.x == 0) (void)xb_add(&bar[XB_XCNT(b.x)], 1u);
    return b;
}
__device__ __forceinline__ void xcd_barrier_complete(unsigned* bar, unsigned x, unsigned& nloc, unsigned& nx) {
    const unsigned G = gridDim.x * gridDim.y * gridDim.z;
    unsigned sum, cnt, mine, sp = 0u;
    for (;;) {
        sum = 0u; cnt = 0u; mine = 0u;
#pragma unroll
        for (unsigned j = 0; j < 16; ++j) { const unsigned c = xb_ld(&bar[XB_XCNT(j)]); sum += c; cnt += (c > 0u) ? 1u : 0u; mine = (j == x) ? c : mine; }
        if (sum == G) break;
        __builtin_amdgcn_s_sleep(1);
        if ((++sp & 255u) == 0u) { if (xb_ld(&bar[XB_TMO])) break; if (sp > XB_SPIN_CAP) { atomicAdd(&bar[XB_TMO], 1u); break; } }
    }
    nloc = mine > 0u ? mine : 1u; nx = cnt > 0u ? cnt : 1u;
}

__device__ __forceinline__ void xcd_barrier(const XcdBarrier& b) {
    asm volatile("s_waitcnt vmcnt(0)" ::: "memory");
    __syncthreads();
    if (threadIdx.x == 0) {
        unsigned* bar = b.bar;
        __builtin_amdgcn_s_waitcnt(0);
        unsigned nloc = b.st[0], nx = b.st[1];
        if (nloc == 0u) { xcd_barrier_complete(bar, b.x, nloc, nx); b.st[0] = nloc; b.st[1] = nx; }
        const unsigned old = xb_add(&bar[XB_XSUB(b.x)], 1u);
        const unsigned gen = old / nloc;
        if (old + 1u == (gen + 1u) * nloc) {
            __builtin_amdgcn_fence(__ATOMIC_RELEASE, "agent");
            asm volatile("s_waitcnt vmcnt(0)" ::: "memory");
            const unsigned og = xb_add(&bar[XB_TOP], 1u);
            const unsigned tg = og / nx;
            if (og + 1u == (tg + 1u) * nx) xb_add(&bar[XB_TOPGEN], 1u);
            else XB_SPIN(xb_ld(&bar[XB_TOPGEN]) == tg, bar);
            __builtin_amdgcn_fence(__ATOMIC_ACQUIRE, "agent");
            xb_add(&bar[XB_XGEN(b.x)], 1u);
            asm volatile("s_waitcnt vmcnt(0)" ::: "memory");
        } else {
            XB_SPIN(xb_ld(&bar[XB_XGEN(b.x)]) == gen, bar);
            __builtin_amdgcn_fence(__ATOMIC_ACQUIRE, "agent");
            asm volatile("s_waitcnt vmcnt(0)" ::: "memory");
        }
    }
    __syncthreads();
}

struct Frame {
    LAS unsigned char* lds;
    volatile LAS unsigned* MISC;
    gu32* ctl;
    int tid, lane, wave;
    int vcu, G;
    const float* in[N_IN]; float* out; unsigned char* ws;
};
__device__ __forceinline__ float bf2f(unsigned short u) { return __uint_as_float((unsigned)u << 16); }
__device__ __forceinline__ float wave_sum(float v) {
#pragma unroll
    for (int o = 1; o < 64; o <<= 1) v += __shfl_xor(v, o);
    return v;
}
__device__ __forceinline__ float wave_max(float v) {
#pragma unroll
    for (int o = 1; o < 64; o <<= 1) v = fmaxf(v, __shfl_xor(v, o));
    return v;
}
template <int MODE>
__device__ __forceinline__ void p0_transpose_item(const float* W, int K, int N, bf16* WT, LAS float* scr, int item, int lane) {
    const int nblk = N / 32, kb = item / nblk, nb = item % nblk, k0 = 64 * kb, n0 = 32 * nb;
#pragma unroll 8
    for (int i = 0; i < 32; ++i) { const int kk = 2 * i + (lane >> 5); scr[kk * 33 + (lane & 31)] = W[(size_t)(k0 + kk) * N + n0 + (lane & 31)]; }
    LDS_WAIT(); asm volatile("" ::: "memory");
    const int c = lane & 7;
    int r0 = n0;
    if (MODE == 1) { const int bj = n0 / FF, rem = n0 - bj * FF; r0 = 256 * (rem >> 7) + 128 * bj + (rem & 127); }
#pragma unroll
    for (int j = 0; j < 4; ++j) { const int n = (lane >> 3) + 8 * j; const LAS float* s = scr + (8 * c) * 33 + n;
        v4u o; o.x = pk2(s[0 * 33], s[1 * 33]); o.y = pk2(s[2 * 33], s[3 * 33]); o.z = pk2(s[4 * 33], s[5 * 33]); o.w = pk2(s[6 * 33], s[7 * 33]);
        *(GAS v4u*)(WT + (size_t)(r0 + n) * K + k0 + 8 * c) = o; }
    LDS_WAIT(); asm volatile("" ::: "memory");
}
__device__ __forceinline__ float silu_f(float x) { return x / (1.0f + expf(-x)); }

__device__ __forceinline__ void p0a_prologue(Frame& F) {
    int tid_ = F.tid; asm volatile("" : "+v"(tid_) :: "memory"); const int P_tid = tid_, P_lane = tid_ & 63, P_wave = __builtin_amdgcn_readfirstlane(tid_ >> 6); (void)P_tid; (void)P_lane; (void)P_wave;

    float* MOD = (float*)(F.ws + WS_MOD); float* TAB = (float*)(F.ws + WS_TAB);
    {
        LAS float* sv = (LAS float*)(F.lds);
        LAS float* red = (LAS float*)(F.lds + 9 * 1024 * 4);
        for (int i = P_tid; i < 9 * 1024; i += NWAVES * 64) { const int bi = i >> 10, k = i & 1023; const float v = bi < 8 ? F.in[I_C][bi * 1024 + k] : F.in[I_CCTX][k]; sv[i] = silu_f(v); }
        __syncthreads();
        for (int it = F.vcu; it < 2 * 96; it += F.G) {
            const int l = it / 96, n0 = (it % 96) * 64;
            const float* W = F.in[I_WADA] + (size_t)l * D * NMOD + n0 + P_lane;
            float acc[9];
#pragma unroll
            for (int b = 0; b < 9; ++b) acc[b] = 0.f;
            const int kbeg = P_wave * 128;
#pragma unroll 8
            for (int k = kbeg; k < kbeg + 128; ++k) { const float w = W[(size_t)k * NMOD];
#pragma unroll
                for (int b = 0; b < 9; ++b) acc[b] += sv[b * 1024 + k] * w; }
#pragma unroll
            for (int b = 0; b < 9; ++b) red[(P_wave * 9 + b) * 64 + P_lane] = acc[b];
            __syncthreads();
            for (int i = P_tid; i < 9 * 64; i += NWAVES * 64) { const int b = i >> 6, n = i & 63; float s = 0.f;
#pragma unroll
                for (int w = 0; w < 8; ++w) s += red[(w * 9 + b) * 64 + n];
                MOD[((size_t)l * 9 + b) * NMOD + n0 + n] = s + F.in[I_BADA][l * NMOD + n0 + n]; }
            __syncthreads();
        }
    }
    if (F.vcu == F.G - 1) {
        for (int i = P_tid; i < 64 * 16; i += NWAVES * 64) { const int pos = i >> 4, f = i & 15; const float ang = (float)pos * exp2f(-(float)f * (13.287712379549449f / 16.0f)); TAB[TAB_ROPEA + 2 * i] = cosf(ang); TAB[TAB_ROPEA + 2 * i + 1] = sinf(ang); }
        for (int i = P_tid; i < 64 * 8; i += NWAVES * 64) { const int pos = i >> 3, f = i & 7; const float ang = (float)pos * exp2f(-(float)f * (13.287712379549449f / 8.0f)); TAB[TAB_ROPEB + 2 * i] = cosf(ang); TAB[TAB_ROPEB + 2 * i + 1] = sinf(ang); }
        if (P_wave == 0) {
            for (int l = 0; l < DEPTH; ++l) {
                float a = P_lane < 32 ? F.in[I_LQ1][l * 32 + P_lane] * F.in[I_LK1][l * 32 + P_lane] : 0.f;
                float b = P_lane < 32 ? F.in[I_LQ2][l * 32 + P_lane] * F.in[I_LK2][l * 32 + P_lane] : 0.f;
                a = wave_sum(a); b = wave_sum(b);
                const float lam_init = 0.8f - 0.6f * expf(-0.3f * (float)l);
                if (P_lane == 0) { TAB[TAB_SCAL + 4 * l] = expf(a) - expf(b) + lam_init; TAB[TAB_SCAL + 4 * l + 1] = 1.0f - lam_init; }
            }
        }
        for (int c = P_tid; c < PW; c += NWAVES * 64) {
            float s = 1.0f;
            if (c < C_AK || (c >= C_CQ && c < C_CK)) s = 0.125f * LOG2E;
            else if (c >= C_BQ && c < C_BK) s = 0.17677669529663687f * LOG2E;
            TAB[TAB_CSCALE + c] = s;
        }
    }
    __syncthreads();
    LAS float* scr = (LAS float*)(F.lds + RING_OFF + P_wave * 16384);
    const int gw = F.vcu * NWAVES + P_wave, NGW = F.G * NWAVES;
    constexpr int I_1 = (D / 64) * (PW / 32), I_2 = (D / 64) * (D / 32), I_3 = (D / 64) * (2 * FF / 32), I_4 = (FF / 64) * (D / 32), I_L = I_1 + I_2 + I_3 + I_4;
    for (int it = gw; it < DEPTH * I_L; it += NGW) {
        const int l = it / I_L; int r = it % I_L;
        unsigned char* wl = F.ws + WS_W + (size_t)l * W_LAYER;
        if (r < I_1) { p0_transpose_item<0>(F.in[I_WIN] + (size_t)l * D * PW, D, PW, (bf16*)(wl + W_IN), scr, r, P_lane); continue; } r -= I_1;
        if (r < I_2) { p0_transpose_item<0>(F.in[I_WO] + (size_t)l * D * D, D, D, (bf16*)(wl + W_O), scr, r, P_lane); continue; } r -= I_2;
        if (r < I_3) { p0_transpose_item<1>(F.in[I_WFI] + (size_t)l * D * 2 * FF, D, 2 * FF, (bf16*)(wl + W_FI), scr, r, P_lane); continue; } r -= I_3;
        p0_transpose_item<0>(F.in[I_WFO] + (size_t)l * FF * D, FF, D, (bf16*)(wl + W_FO), scr, r, P_lane);
    }
}
__device__ __forceinline__ float* res_row(Frame& F, int r) { return r < MLAT ? F.out + (size_t)r * D : (float*)(F.ws + WS_RC) + (size_t)(r - MLAT) * D; }
__device__ __forceinline__ const float* in_row(Frame& F, int r) { return r < MLAT ? F.in[I_X] + (size_t)r * D : F.in[I_CTX] + (size_t)(r - MLAT) * D; }
__device__ __forceinline__ int row_bi(int r) { return r < MLAT ? (r >> 11) : 8; }
__device__ __forceinline__ void p0b_modulate(Frame& F) {
    int tid_ = F.tid; asm volatile("" : "+v"(tid_) :: "memory"); const int P_tid = tid_, P_lane = tid_ & 63, P_wave = __builtin_amdgcn_readfirstlane(tid_ >> 6); (void)P_tid; (void)P_lane; (void)P_wave;

    const float* MOD = (const float*)(F.ws + WS_MOD); bf16* HA = (bf16*)(F.ws + WS_HA);
    const int gw = F.vcu * NWAVES + P_wave, NGW = F.G * NWAVES;
    for (int r = gw; r < MALL; r += NGW) {
        const GAS f32x4* xr = (const GAS f32x4*)in_row(F, r) + P_lane; const float* md = MOD + (size_t)row_bi(r) * NMOD;
        GAS unsigned long long* o8 = (GAS unsigned long long*)(HA + (size_t)r * D) + P_lane;
#pragma unroll
        for (int j = 0; j < 4; ++j) { const f32x4 v = xr[64 * j]; const int c = 4 * P_lane + 256 * j; const f32x4 sh = *(const f32x4*)(md + c), sc = *(const f32x4*)(md + D + c);
            const f32x4 h = v * (sc + 1.0f) + sh; o8[64 * j] = (unsigned long long)pk2(h.x, h.y) | ((unsigned long long)pk2(h.z, h.w) << 32); }
    }
}
__device__ __forceinline__ void ln_pass(Frame& F, int nrows, const float* lng, const float* lnb, const float* mod  , int sh_off) {
    int tid_ = F.tid; asm volatile("" : "+v"(tid_) :: "memory"); const int P_tid = tid_, P_lane = tid_ & 63, P_wave = __builtin_amdgcn_readfirstlane(tid_ >> 6); (void)P_tid; (void)P_lane; (void)P_wave;

    bf16* HA = (bf16*)(F.ws + WS_HA);
    const int gw = F.vcu * NWAVES + P_wave, NGW = F.G * NWAVES;
    for (int r = gw; r < nrows; r += NGW) {
        float* rr = res_row(F, r); GAS f32x4* xr = (GAS f32x4*)rr + P_lane;
        f32x4 v[4]; float s = 0.f;
#pragma unroll
        for (int j = 0; j < 4; ++j) { v[j] = xr[64 * j]; s += (v[j].x + v[j].y) + (v[j].z + v[j].w); }
        const float mean = wave_sum(s) * (1.f / D); float s2 = 0.f;
#pragma unroll
        for (int j = 0; j < 4; ++j) { v[j] = v[j] - mean; s2 += (v[j].x * v[j].x + v[j].y * v[j].y) + (v[j].z * v[j].z + v[j].w * v[j].w); }
        const float rstd = 1.f / sqrtf(wave_sum(s2) * (1.f / D) + LN_EPS);
        const float* md = mod ? mod + (size_t)row_bi(r) * NMOD + sh_off : nullptr;
        GAS unsigned long long* o8 = (GAS unsigned long long*)(HA + (size_t)r * D) + P_lane;
#pragma unroll
        for (int j = 0; j < 4; ++j) { const int c = 4 * P_lane + 256 * j; const f32x4 g = *(const f32x4*)(lng + c), b = *(const f32x4*)(lnb + c);
            const f32x4 y = v[j] * rstd * g + b; xr[64 * j] = y;
            if (md) { const f32x4 sh = *(const f32x4*)(md + c), sc = *(const f32x4*)(md + D + c); const f32x4 h = y * (sc + 1.0f) + sh;
                o8[64 * j] = (unsigned long long)pk2(h.x, h.y) | ((unsigned long long)pk2(h.z, h.w) << 32); } }
    }
}
__device__ __forceinline__ void rope_pass(Frame& F) {
    int tid_ = F.tid; asm volatile("" : "+v"(tid_) :: "memory"); const int P_tid = tid_, P_lane = tid_ & 63, P_wave = __builtin_amdgcn_readfirstlane(tid_ >> 6); (void)P_tid; (void)P_lane; (void)P_wave;

    bf16* P = (bf16*)(F.ws + WS_P); const float* TAB = (const float*)(F.ws + WS_TAB);
    const int gt = F.vcu * NWAVES * 64 + P_tid, NT = F.G * NWAVES * 64;
    for (long idx = gt; idx < (long)MLAT * 512; idx += NT) {
        const int r = (int)(idx >> 9), p = (int)(idx & 511); const int t = r & (SEQ - 1), prow = t >> 6, pcol = t & 63;
        int c1, c2, pos, fi; bool isA;
        if (p < 256) { const int h = p >> 5, q = p & 31; const int hb = (h < 6 ? C_AQ + h * 64 : C_AK + (h - 6) * 64); isA = true;
            if (q < 16) { c1 = hb + q; c2 = hb + 16 + q; pos = prow; fi = q; } else { c1 = hb + 32 + (q - 16); c2 = hb + 48 + (q - 16); pos = pcol; fi = q - 16; } }
        else { const int pp = p - 256, v = pp >> 4, q = pp & 15; const int vb = (v < 8 ? C_BQ + v * 32 : C_BK + (v - 8) * 32); isA = false;
            if (q < 8) { c1 = vb + q; c2 = vb + 8 + q; pos = prow; fi = q; } else { c1 = vb + 16 + (q - 8); c2 = vb + 24 + (q - 8); pos = pcol; fi = q - 8; } }
        const float cs = isA ? TAB[TAB_ROPEA + 2 * (pos * 16 + fi)] : TAB[TAB_ROPEB + 2 * (pos * 8 + fi)];
        const float sn = isA ? TAB[TAB_ROPEA + 2 * (pos * 16 + fi) + 1] : TAB[TAB_ROPEB + 2 * (pos * 8 + fi) + 1];
        bf16* row = P + (size_t)r * PW; const float x1 = bf2f(row[c1]), x2 = bf2f(row[c2]);
        row[c1] = (bf16)f2bf(x1 * cs - x2 * sn); row[c2] = (bf16)f2bf(x2 * cs + x1 * sn);
    }
}

namespace naive {
constexpr int MAXK = 2304;
__device__ __forceinline__ void load64(const bf16* p, float* v) {
#pragma unroll
    for (int i = 0; i < 8; ++i) { const v4u w = *(const v4u*)(p + 8 * i);
        v[8 * i + 0] = __uint_as_float(w.x << 16); v[8 * i + 1] = __uint_as_float(w.x & 0xffff0000u); v[8 * i + 2] = __uint_as_float(w.y << 16); v[8 * i + 3] = __uint_as_float(w.y & 0xffff0000u);
        v[8 * i + 4] = __uint_as_float(w.z << 16); v[8 * i + 5] = __uint_as_float(w.z & 0xffff0000u); v[8 * i + 6] = __uint_as_float(w.w << 16); v[8 * i + 7] = __uint_as_float(w.w & 0xffff0000u); }
}
template <int VAR> __device__ __forceinline__ void attn_item(int item, int lane, LAS float* s1, LAS float* s2, const bf16* __restrict__ P, bf16* __restrict__ MIX, const float* __restrict__ sinkv, const float* __restrict__ nab, const float* __restrict__ scal, const float* __restrict__ subg) {
    constexpr bool LAT = (VAR % 2) == 0; constexpr int KIND = VAR / 2; constexpr int NH = (KIND == 1) ? 4 : 6;
    const int ri = item / NH, h = item % NH;
    const int row = LAT ? ri : MLAT + ri; const int b = LAT ? (ri >> 11) : (ri >> 8); const int t = ri & (SEQ - 1);
    const int qcol = KIND == 0 ? C_AQ + h * 64 : (KIND == 1 ? C_BQ + h * 64 : C_CQ + h * 64);
    const int kcol = KIND == 0 ? C_AK + (h / 3) * 64 : (KIND == 1 ? C_BK + h * 64 : C_CK + h * 64);
    const int vcol = KIND == 0 ? C_AV + (h / 3) * 64 : (KIND == 1 ? C_BV + h * 64 : C_CV + h * 64);
    float q[64]; load64(P + (size_t)row * PW + qcol, q);
    int nloc = 0, lo = 0, rs = 0, cs = 0; const int qr = t >> 6, qw = t & 63;
    if (LAT) {
        if (KIND == 0) { lo = max(0, t - 128); const int hi = min(SEQ - 1, t + 128); nloc = hi - lo + 1; }
        else if (KIND == 1) { nloc = SEQ; }
        else { rs = min(max(qr - 4, 0), 24); cs = min(max(qw - 8, 0), 48); nloc = 128; }
    }
    const int nk = nloc + CTXL;
    float m1 = -INFINITY, m2 = -INFINITY;
    for (int j = lane; j < nk; j += 64) {
        int krow; float bias = 0.f;
        if (j < nloc) {
            int tk;
            if (KIND == 0) tk = lo + j; else if (KIND == 1) tk = j; else { const int kr = rs + (j >> 4), kc = cs + (j & 15); tk = kr * 64 + kc;
                const int dr = kr - qr + 7, dc = min(max(kc - qw, -15), 15) + 15; bias = nab[(h * 15 + dr) * 31 + dc] * LOG2E; }
            krow = b * SEQ + tk;
        } else krow = MLAT + b * CTXL + (j - nloc);
        float kv[64]; load64(P + (size_t)krow * PW + kcol, kv);
        if (KIND == 1) { float d1 = 0.f, d2 = 0.f;
#pragma unroll
            for (int d = 0; d < 32; ++d) { d1 += q[d] * kv[d]; d2 += q[32 + d] * kv[32 + d]; }
            s1[j] = d1; s2[j] = d2; m1 = fmaxf(m1, d1); m2 = fmaxf(m2, d2);
        } else { float d1 = 0.f;
#pragma unroll
            for (int d = 0; d < 64; ++d) d1 += q[d] * kv[d];
            d1 += bias; s1[j] = d1; m1 = fmaxf(m1, d1); }
    }
    float sk = -INFINITY; if (KIND == 0) { sk = sinkv[h] * LOG2E; m1 = fmaxf(m1, sk); }
    m1 = wave_max(m1); if (KIND == 1) m2 = wave_max(m2);
    float l1 = 0.f, l2 = 0.f;
    for (int j = lane; j < nk; j += 64) { const float p = exp2f(s1[j] - m1); s1[j] = p; l1 += p; if (KIND == 1) { const float p2 = exp2f(s2[j] - m2); s2[j] = p2; l2 += p2; } }
    l1 = wave_sum(l1); if (KIND == 1) l2 = wave_sum(l2); if (KIND == 0) l1 += exp2f(sk - m1);
    __builtin_amdgcn_s_waitcnt(0xC07F); asm volatile("" ::: "memory");
    const float lam = (KIND == 1) ? scal[0] : 0.f;
    const float i1 = 1.0f / l1, i2 = (KIND == 1) ? lam / l2 : 0.f;
    float o = 0.f;
    for (int j = 0; j < nk; ++j) {
        int krow;
        if (j < nloc) { int tk; if (KIND == 0) tk = lo + j; else if (KIND == 1) tk = j; else tk = (rs + (j >> 4)) * 64 + cs + (j & 15); krow = b * SEQ + tk; }
        else krow = MLAT + b * CTXL + (j - nloc);
        const float w = (KIND == 1) ? (s1[j] * i1 - s2[j] * i2) : s1[j] * i1;
        o += w * bf2f(P[(size_t)krow * PW + vcol + lane]);
    }
    if (KIND == 1) { const float ms = wave_sum(o * o) * (1.0f / 64.0f); o = o * (1.0f / sqrtf(ms + LN_EPS)) * subg[lane] * scal[1]; }
    const int mcol = KIND == 0 ? M_A + h * 64 : (KIND == 1 ? M_B + h * 64 : M_C + h * 64);
    MIX[(size_t)row * D + mcol + lane] = (bf16)f2bf(o);
}
template <int VAR> __device__ __forceinline__ int n_items() { return ((VAR % 2) == 0 ? MLAT : MCTX) * ((VAR / 2) == 1 ? 4 : 6); }
template <int VAR> __device__ __forceinline__ void attn_phase(LAS unsigned char* lds, int vcu, int G, const bf16* P, bf16* MIX, const float* sinkv, const float* nab, const float* scal, const float* subg) {
    int tid_ = threadIdx.x; asm volatile("" : "+v"(tid_) :: "memory"); const int lane = tid_ & 63, wave = __builtin_amdgcn_readfirstlane(tid_ >> 6);
    constexpr bool TWO = (VAR / 2) == 1; constexpr int WPB = TWO ? 4 : 8;
    if (wave >= WPB) return;
    LAS float* s1 = (LAS float*)(lds + wave * (TWO ? 32768 : 16384)); LAS float* s2 = s1 + 4096;
    for (int item = vcu * WPB + wave; item < n_items<VAR>(); item += G * WPB) attn_item<VAR>(item, lane, s1, s2, P, MIX, sinkv, nab, scal, subg);
}
}

constexpr int PH_P0A = 0, PH_P0B = 1, PH_L0 = 2, PH_PER_LAYER = 8, PH_END = PH_L0 + DEPTH * PH_PER_LAYER;
struct Args { const float* in[N_IN]; float* out; unsigned char* ws; int ph_lo, ph_hi; };
__global__ void __launch_bounds__(NWAVES * 64, 2) skel_fwd(Args args) {
    extern __shared__ __attribute__((aligned(16))) unsigned char lds[];
    Frame F;
    F.lds = (LAS unsigned char*)lds;
    F.MISC = (volatile LAS unsigned*)(F.lds + MISC_OFF);
    F.tid = threadIdx.x; F.lane = F.tid & 63; F.wave = __builtin_amdgcn_readfirstlane(F.tid >> 6);
    F.G = gridDim.x; { const int bx = blockIdx.x; F.vcu = (F.G % 8 == 0) ? (bx % 8) * (F.G / 8) + bx / 8 : bx; }
    F.ws = args.ws; F.out = args.out; F.ctl = (gu32*)(args.ws + WS_CTL);
#pragma unroll
    for (int i = 0; i < N_IN; ++i) F.in[i] = args.in[i];
    for (int u = F.tid; u < (LDS_BYTES - LDSCTL_OFF) / 4; u += NWAVES * 64) ((LAS unsigned*)(F.lds + LDSCTL_OFF))[u] = 0u;
    __syncthreads();
    const int lo = args.ph_lo, hi = args.ph_hi;
    const bool multi = (hi - lo) > 1;
    XcdBarrier bar; bar.bar = (unsigned*)(F.ctl + CW_BAR); bar.x = 0; bar.st = nullptr;
    if (multi) bar = xcd_barrier_post((unsigned*)(F.ctl + CW_BAR), F.MISC + 8);
#define IN(k) (lo <= (k) && (k) < hi)
#define SEAM(k) do { if (IN(k) && IN((k) + 1)) xcd_barrier(bar); } while (0)
    const float* MOD = (const float*)(F.ws + WS_MOD); const float* TAB = (const float*)(F.ws + WS_TAB);
    bf16* HA = (bf16*)(F.ws + WS_HA); bf16* P = (bf16*)(F.ws + WS_P); bf16* MIX = (bf16*)(F.ws + WS_MIX); bf16* HID = (bf16*)(F.ws + WS_HID);
    float* RC = (float*)(F.ws + WS_RC);

    if (IN(PH_P0A)) { p0a_prologue(F); } SEAM(PH_P0A);
    if (IN(PH_P0B)) { p0b_modulate(F); } SEAM(PH_P0B);
#pragma unroll 1
    for (int l = 0; l < DEPTH; ++l) {
        const int pb = PH_L0 + l * PH_PER_LAYER; const bool last = (l == DEPTH - 1);
        const unsigned char* wl = F.ws + WS_W + (size_t)l * W_LAYER; const float* modl = MOD + (size_t)l * 9 * NMOD;
        const int Mrest = last ? MLAT : MALL;
        if (IN(pb + 0)) {
            pg8::Gemm g{HA, (const bf16*)(wl + W_IN), MALL, PW, D}; pg8::StaticOrder S; S.init(MALL, PW, F.G, (int)blockIdx.x);
            pg8::EpiProj E{P, PW, TAB + TAB_CSCALE};
            pg8::gemm_phase<pg8::EpiProj, pg8::StaticOrder, PG8_ALIGN, PG8_SP2>(F.lds + RING_OFF, g, S, E);
        } SEAM(pb + 0);
        if (IN(pb + 1)) { rope_pass(F); } SEAM(pb + 1);
        if (IN(pb + 2)) {
            const float* sink = F.in[I_SINK] + l * 6; const float* nab = F.in[I_NAB] + l * 6 * 15 * 31; const float* subg = F.in[I_SUBG] + l * 64; const float* scal = TAB + TAB_SCAL + 4 * l;
            naive::attn_phase<0>(F.lds, F.vcu, F.G, P, MIX, sink, nab, scal, subg); __syncthreads();
            naive::attn_phase<2>(F.lds, F.vcu, F.G, P, MIX, sink, nab, scal, subg); __syncthreads();
            naive::attn_phase<4>(F.lds, F.vcu, F.G, P, MIX, sink, nab, scal, subg); __syncthreads();
            if (l == 0) {
                naive::attn_phase<1>(F.lds, F.vcu, F.G, P, MIX, sink, nab, scal, subg); __syncthreads();
                naive::attn_phase<3>(F.lds, F.vcu, F.G, P, MIX, sink, nab, scal, subg); __syncthreads();
                naive::attn_phase<5>(F.lds, F.vcu, F.G, P, MIX, sink, nab, scal, subg); __syncthreads();
            }
        } SEAM(pb + 2);
        if (IN(pb + 3)) {
            pg8::Gemm g{MIX, (const bf16*)(wl + W_O), Mrest, D, D}; pg8::StaticOrder S; S.init(Mrest, D, F.G, (int)blockIdx.x);
            pg8::EpiRes E{l == 0 ? F.in[I_X] : F.out, l == 0 ? F.in[I_CTX] : RC, F.out, RC, modl, 2 * D, ALPHA};
            pg8::gemm_phase<pg8::EpiRes, pg8::StaticOrder, PG8_ALIGN, PG8_SP2>(F.lds + RING_OFF, g, S, E);
        } SEAM(pb + 3);
        if (IN(pb + 4)) { ln_pass(F, Mrest, F.in[I_LN1G] + l * D, F.in[I_LN1B] + l * D, modl, 3 * D); } SEAM(pb + 4);
        if (IN(pb + 5)) {
            pg8::Gemm g{HA, (const bf16*)(wl + W_FI), Mrest, 2 * FF, D}; pg8::StaticOrder S; S.init(Mrest, 2 * FF, F.G, (int)blockIdx.x);
            pg8::EpiSwiglu E{HID, FF};
            pg8::gemm_phase<pg8::EpiSwiglu, pg8::StaticOrder, PG8_ALIGN, PG8_SP2>(F.lds + RING_OFF, g, S, E);
        } SEAM(pb + 5);
        if (IN(pb + 6)) {
            pg8::Gemm g{HID, (const bf16*)(wl + W_FO), Mrest, D, FF}; pg8::StaticOrder S; S.init(Mrest, D, F.G, (int)blockIdx.x);
            pg8::EpiRes E{F.out, RC, F.out, RC, modl, 5 * D, ALPHA};
            pg8::gemm_phase<pg8::EpiRes, pg8::StaticOrder, PG8_ALIGN, PG8_SP2>(F.lds + RING_OFF, g, S, E);
        } SEAM(pb + 6);
        if (IN(pb + 7)) { ln_pass(F, Mrest, F.in[I_LN2G] + l * D, F.in[I_LN2B] + l * D, last ? nullptr : modl + 9 * NMOD, 0); } SEAM(pb + 7);
    }
#undef IN
#undef SEAM
}

extern "C" void kernel_launch(void* const* d_in, const int* in_sizes, int n_in, void* d_out, int out_size, void* d_ws, size_t ws_size, hipStream_t stream) {
    static int grid = 0;
    if (grid == 0) {
        if (n_in != N_IN || in_sizes[0] != MLAT * D || out_size != MLAT * D || ws_size < WS_END) { fprintf(stderr, "kernel_launch: unexpected shapes (n_in %d, in0 %d, out %d, ws %zu); nothing launched\n", n_in, n_in > 0 ? in_sizes[0] : -1, out_size, ws_size); grid = -1; return; }
        int dev = 0, cus = 0, per_cu = 0;
        if (hipGetDevice(&dev) != hipSuccess || hipDeviceGetAttribute(&cus, hipDeviceAttributeMultiprocessorCount, dev) != hipSuccess) { grid = -1; return; }
        if (hipFuncSetAttribute((const void*)skel_fwd, hipFuncAttributeMaxDynamicSharedMemorySize, LDS_BYTES) != hipSuccess) { fprintf(stderr, "kernel_launch: hipFuncSetAttribute failed\n"); grid = -1; return; }
        if (hipOccupancyMaxActiveBlocksPerMultiprocessor(&per_cu, (const void*)skel_fwd, NWAVES * 64, LDS_BYTES) != hipSuccess || per_cu < 1) { fprintf(stderr, "kernel_launch: occupancy query reports %d\n", per_cu); per_cu = 1; }
        (void)hipGetLastError();
        grid = cus;
    }
    if (grid < 0) return;
    (void)hipMemsetAsync((char*)d_ws + WS_CTL, 0, CTL_ZERO_BYTES, stream);
    Args a{};
    for (int i = 0; i < N_IN; ++i) a.in[i] = (const float*)d_in[i];
    a.out = (float*)d_out; a.ws = (unsigned char*)d_ws;
    a.ph_lo = 0; a.ph_hi = PH_END;
    hipLaunchKernelGGL(skel_fwd, dim3(grid), dim3(NWAVES * 64), LDS_BYTES, stream, a);
}
```

```cpp
#include <hip/hip_runtime.h>
#include <hip/hip_bf16.h>
#include <cstdio>
#include <cstdint>
#include <cmath>
namespace pg8 {
#define PG8_LAS __attribute__((address_space(3)))
typedef unsigned short bf16_t;
typedef short bf16x8 __attribute__((ext_vector_type(8)));
typedef float f32x4 __attribute__((ext_vector_type(4)));
typedef unsigned u32x4 __attribute__((ext_vector_type(4)));
constexpr int BM = 256, BK = 64, HALF = 128, HTB = HALF * BK * 2  , STAGE_BYTES = 8 * HTB, NXCD = 8, WGM = 8;

__host__ __device__ __forceinline__ int lds_byte(int r, int c) { const int st = (r >> 4) * 2 + (c >> 5), rr = r & 15, cc = c & 31, ob = rr * 64 + cc * 2; return st * 1024 + (ob ^ (((ob >> 9) & 1) << 5)); }
__host__ __device__ __forceinline__ void stage_rc(int b, int& R, int& C) { const int st = b / 1024, sb = b % 1024, swz = sb ^ (((sb >> 9) & 1) << 5); R = (st >> 1) * 16 + swz / 64; C = (st & 1) * 32 + (swz % 64) / 2; }
__host__ __device__ __forceinline__ int perm32(int rho) { const int n = rho >> 4, i = rho & 15; return 8 * (i >> 2) + 4 * n + (i & 3); }

struct Unit { int pm, pn; };
struct Gemm { const bf16_t* A; const bf16_t* Bt; int M, N, K; };

struct StaticOrder {
    int nM, nN, nwg, G, c;
    __host__ __device__ void init(int M, int N, int G_, int c_) { nM = M / BM; nN = N / BM; nwg = nM * nN; G = G_; c = c_; }
    __host__ __device__ bool next(int i, Unit& u) const {
        const long L = (long)i * G + c; if (L >= nwg) return false;
        int wgid = (int)L; { const int q = nwg / NXCD, r = nwg % NXCD, xcd = wgid % NXCD, off = wgid / NXCD; wgid = (xcd < r ? xcd * (q + 1) : r * (q + 1) + (xcd - r) * q) + off; }
        const int nig = WGM * nN, gid = wgid / nig, fm = gid * WGM, gsz = (nM - fm) < WGM ? (nM - fm) : WGM;
        u.pm = fm + ((wgid % nig) % gsz); u.pn = (wgid % nig) / gsz; return true;
    }
    __device__ __forceinline__ void a_ready(const Unit&) const {}
    __device__ __forceinline__ void done(const Unit&) const {}
};

__device__ __forceinline__ unsigned cvt_pk_bf16(float lo, float hi) { unsigned r; asm volatile("v_cvt_pk_bf16_f32 %0, %1, %2" : "=v"(r) : "v"(lo), "v"(hi)); return r; }

struct EpiProj {
    static constexpr bool PERM = true, AFTER_DRAIN = false;
    bf16_t* O; int ldc; const float* cscale;
    __device__ __forceinline__ void operator()(const f32x4 (&acc)[2][2][4][2], const Unit& u, int wr, int wc, int fr, int fq) const {
        const int row0 = u.pm * BM + wr * 64 + fr; const int col0 = u.pn * BM + wc * 32 + 8 * fq;
        f32x4 sv[2][2];
#pragma unroll
        for (int bj = 0; bj < 2; ++bj)
#pragma unroll
            for (int n = 0; n < 2; ++n) sv[bj][n] = *(const f32x4*)(cscale + col0 + bj * HALF + 4 * n);
#pragma unroll
        for (int ai = 0; ai < 2; ++ai)
#pragma unroll
            for (int m = 0; m < 4; ++m) { bf16_t* rowp = O + (size_t)(row0 + ai * HALF + m * 16) * ldc + col0;
#pragma unroll
                for (int bj = 0; bj < 2; ++bj) { const f32x4 v0 = acc[ai][bj][m][0] * sv[bj][0], v1 = acc[ai][bj][m][1] * sv[bj][1];
                    u32x4 w; w.x = cvt_pk_bf16(v0[0], v0[1]); w.y = cvt_pk_bf16(v0[2], v0[3]); w.z = cvt_pk_bf16(v1[0], v1[1]); w.w = cvt_pk_bf16(v1[2], v1[3]);
                    *(u32x4*)(rowp + bj * HALF) = w; } }
    }
};
struct EpiRes {
    static constexpr bool PERM = false, AFTER_DRAIN = false;
    const float* res_lat; const float* res_ctx; float* out_lat; float* out_ctx; const float* mod  ; int gate_off; float alpha;
    __device__ __forceinline__ void operator()(const f32x4 (&acc)[2][2][4][2], const Unit& u, int wr, int wc, int fr, int fq) const {
        const int rowt = u.pm * BM; const bool isctx = rowt >= 16384;
        const float* rb = isctx ? res_ctx + (size_t)(rowt - 16384) * 1024 : res_lat + (size_t)rowt * 1024;
        float* ob = isctx ? out_ctx + (size_t)(rowt - 16384) * 1024 : out_lat + (size_t)rowt * 1024;
        const int bi = isctx ? 8 : (rowt >> 11);
        const int col0 = u.pn * BM + wc * 32 + 4 * fq;
        const float* gv = mod + bi * 6144 + gate_off + col0;
        f32x4 g[2][2];
#pragma unroll
        for (int bj = 0; bj < 2; ++bj)
#pragma unroll
            for (int n = 0; n < 2; ++n) g[bj][n] = *(const f32x4*)(gv + bj * HALF + n * 16);
#pragma unroll
        for (int ai = 0; ai < 2; ++ai)
#pragma unroll
            for (int m = 0; m < 4; ++m) { const size_t off = (size_t)(wr * 64 + fr + ai * HALF + m * 16) * 1024 + col0;
#pragma unroll
                for (int bj = 0; bj < 2; ++bj)
#pragma unroll
                    for (int n = 0; n < 2; ++n) { const f32x4 r = *(const f32x4*)(rb + off + bj * HALF + n * 16);
                        *(f32x4*)(ob + off + bj * HALF + n * 16) = r * alpha + g[bj][n] * acc[ai][bj][m][n]; }
                if (m & 1) asm volatile("" ::: "memory"); }
    }
};
__device__ __forceinline__ float silu_mul(float g, float u) { return g * u * __builtin_amdgcn_rcpf(1.0f + __builtin_amdgcn_exp2f(-1.4426950408889634f * g)); }
struct EpiSwiglu {
    static constexpr bool PERM = true, AFTER_DRAIN = false;
    bf16_t* O; int ldc;
    __device__ __forceinline__ void operator()(const f32x4 (&acc)[2][2][4][2], const Unit& u, int wr, int wc, int fr, int fq) const {
        const int row0 = u.pm * BM + wr * 64 + fr; const int col0 = u.pn * HALF + wc * 32 + 8 * fq;
#pragma unroll
        for (int ai = 0; ai < 2; ++ai)
#pragma unroll
            for (int m = 0; m < 4; ++m) { bf16_t* rowp = O + (size_t)(row0 + ai * HALF + m * 16) * ldc + col0;
                const f32x4 g0 = acc[ai][0][m][0], g1 = acc[ai][0][m][1], u0 = acc[ai][1][m][0], u1 = acc[ai][1][m][1];
                u32x4 w; w.x = cvt_pk_bf16(silu_mul(g0[0], u0[0]), silu_mul(g0[1], u0[1])); w.y = cvt_pk_bf16(silu_mul(g0[2], u0[2]), silu_mul(g0[3], u0[3]));
                w.z = cvt_pk_bf16(silu_mul(g1[0], u1[0]), silu_mul(g1[1], u1[1])); w.w = cvt_pk_bf16(silu_mul(g1[2], u1[2]), silu_mul(g1[3], u1[3]));
                *(u32x4*)rowp = w; }
    }
};

template <class Epi, class Sched, bool ALIGN_EPI = false, bool SP2 = false>
__device__ __forceinline__ void gemm_phase(PG8_LAS unsigned char* lds, const Gemm g, const Sched& S, const Epi& E) {
    int tid_ = threadIdx.x; asm volatile("" : "+v"(tid_) :: "memory"); const int tid = tid_, wid = __builtin_amdgcn_readfirstlane(tid >> 6), lane = tid & 63, wr = wid >> 2, wc = wid & 3, fr = lane & 15, fq = lane >> 4;
    const int K = g.K, nt = K / BK;
    unsigned voffA[2], voffB[2];
#pragma unroll
    for (int i = 0; i < 2; ++i) { int R, C; stage_rc(tid * 16 + i * 8192, R, C); const int Rb = Epi::PERM ? ((R & ~31) + perm32(R & 31)) : R;
        voffA[i] = (unsigned)(R * K + C) * 2u; voffB[i] = (unsigned)(Rb * K + C) * 2u; }
    const size_t kstep = (size_t)(BK * 2);
    const size_t hstep = (size_t)HALF * K * 2;
    const size_t tstep = 2 * hstep;
    const unsigned ldsw = (unsigned)wid * 1024u;
    const int aoff = lds_byte(wr * 64 + fr, fq * 8), boff = lds_byte(wc * 32 + fr, fq * 8);
#define PG8_SA(b, h) (((b) * 2 + (h)) * HTB)
#define PG8_SB(b, h) ((4 + (b) * 2 + (h)) * HTB)
#define PG8_STAGE(bufoff, gbase, voff) do { _Pragma("unroll") for (int _i = 0; _i < 2; ++_i) \
        __builtin_amdgcn_global_load_lds((const unsigned*)((const char*)(gbase) + (voff)[_i]), (PG8_LAS unsigned*)(lds + (bufoff) + ldsw + _i * 8192), 16, 0, 0); } while (0)
#define PG8_LDA(dst, b, h) do { _Pragma("unroll") for (int m = 0; m < 4; ++m) _Pragma("unroll") for (int k = 0; k < 2; ++k) dst[m][k] = *(const PG8_LAS bf16x8*)(lds + PG8_SA(b, h) + aoff + m * 2048 + k * 1024); } while (0)
#define PG8_LDB(dst, b, h) do { _Pragma("unroll") for (int n = 0; n < 2; ++n) _Pragma("unroll") for (int k = 0; k < 2; ++k) dst[n][k] = *(const PG8_LAS bf16x8*)(lds + PG8_SB(b, h) + boff + n * 2048 + k * 1024); } while (0)
#define PG8_MMA(ai, bj, At, Bt) do { __builtin_amdgcn_s_setprio(1); _Pragma("unroll") for (int m = 0; m < 4; ++m) _Pragma("unroll") for (int n = 0; n < 2; ++n) _Pragma("unroll") for (int k = 0; k < 2; ++k) \
        acc[ai][bj][m][n] = __builtin_amdgcn_mfma_f32_16x16x32_bf16(Bt[n][k], At[m][k], acc[ai][bj][m][n], 0, 0, 0); __builtin_amdgcn_s_setprio(0); } while (0)
#define PG8_WAIT_V(n) asm volatile("s_waitcnt vmcnt(" #n ")" ::: "memory")
#define PG8_WAIT_L(n) asm volatile("s_waitcnt lgkmcnt(" #n ")" ::: "memory")
#define PG8_BAR __builtin_amdgcn_s_barrier()
#define PG8_SCHED __builtin_amdgcn_sched_barrier(0)
    Unit cur, nxt; int ui = 0;
    if (!S.next(0, cur)) return;
    f32x4 acc[2][2][4][2];
#pragma unroll
    for (int a = 0; a < 2; ++a)
#pragma unroll
        for (int b = 0; b < 2; ++b)
#pragma unroll
            for (int m = 0; m < 4; ++m)
#pragma unroll
                for (int n = 0; n < 2; ++n) acc[a][b][m][n] = (f32x4){0.f, 0.f, 0.f, 0.f};
    bf16x8 At[4][2], B0[2][2], B1[2][2];
    const char* cA = (const char*)g.A + (size_t)cur.pm * tstep; const char* cB = (const char*)g.Bt + (size_t)cur.pn * tstep;
    S.a_ready(cur);
    if constexpr (SP2) {
        PG8_STAGE(PG8_SB(0, 0), cB, voffB); PG8_STAGE(PG8_SB(0, 1), cB + hstep, voffB); PG8_STAGE(PG8_SA(0, 0), cA, voffA); PG8_STAGE(PG8_SA(0, 1), cA + hstep, voffA);
        if (wr == 1) PG8_BAR;
        PG8_WAIT_V(2); PG8_BAR;
        PG8_STAGE(PG8_SB(1, 0), cB + kstep, voffB); PG8_STAGE(PG8_SA(1, 0), cA + kstep, voffA); PG8_STAGE(PG8_SB(1, 1), cB + hstep + kstep, voffB);
        PG8_WAIT_V(6); PG8_BAR;
    } else {
        PG8_STAGE(PG8_SB(0, 0), cB, voffB); PG8_STAGE(PG8_SA(0, 0), cA, voffA); PG8_STAGE(PG8_SB(0, 1), cB + hstep, voffB); PG8_STAGE(PG8_SA(0, 1), cA + hstep, voffA);
        if (wr == 1) PG8_BAR;
        PG8_WAIT_V(4); PG8_BAR;
        PG8_STAGE(PG8_SB(1, 0), cB + kstep, voffB); PG8_STAGE(PG8_SA(1, 0), cA + kstep, voffA); PG8_STAGE(PG8_SB(1, 1), cB + hstep + kstep, voffB);
        PG8_WAIT_V(6); PG8_BAR;
    }
    for (;;) {
        const bool has_next = S.next(ui + 1, nxt);
        const char* nA = has_next ? (const char*)g.A + (size_t)nxt.pm * tstep : cA; const char* nB = has_next ? (const char*)g.Bt + (size_t)nxt.pn * tstep : cB;
        for (int t = 0; t < nt; t += 2) {
            const bool last = (t == nt - 2);
            const char* a1 = cA + (size_t)(t + 1) * kstep;
            const char* a2 = last ? nA : cA + (size_t)(t + 2) * kstep; const char* b2 = last ? nB : cB + (size_t)(t + 2) * kstep;
            const char* a3 = a2 + kstep; const char* b3 = b2 + kstep;
            if (last && has_next) S.a_ready(nxt);
            if constexpr (SP2) {
            PG8_LDB(B0, 0, 0); PG8_LDB(B1, 0, 1); PG8_SCHED; PG8_LDA(At, 0, 0); PG8_STAGE(PG8_SA(1, 1), a1 + hstep, voffA);
            PG8_WAIT_V(8); PG8_WAIT_L(0); PG8_BAR; PG8_MMA(0, 0, At, B0); PG8_MMA(0, 1, At, B1); PG8_BAR; PG8_SCHED;
            PG8_LDA(At, 0, 1); PG8_STAGE(PG8_SB(0, 0), b2, voffB); PG8_STAGE(PG8_SB(0, 1), b2 + hstep, voffB); PG8_STAGE(PG8_SA(0, 0), a2, voffA);
            PG8_WAIT_V(8); PG8_WAIT_L(0); PG8_BAR; PG8_MMA(1, 0, At, B0); PG8_MMA(1, 1, At, B1); PG8_BAR; PG8_SCHED;
            PG8_LDB(B0, 1, 0); PG8_LDB(B1, 1, 1); PG8_SCHED; PG8_LDA(At, 1, 0); PG8_STAGE(PG8_SA(0, 1), a2 + hstep, voffA);
            PG8_WAIT_V(8); PG8_WAIT_L(0); PG8_BAR; PG8_MMA(0, 0, At, B0); PG8_MMA(0, 1, At, B1); PG8_BAR; PG8_SCHED;
            PG8_LDA(At, 1, 1); PG8_STAGE(PG8_SB(1, 0), b3, voffB); PG8_STAGE(PG8_SB(1, 1), b3 + hstep, voffB); PG8_STAGE(PG8_SA(1, 0), a3, voffA);
            PG8_WAIT_V(8); PG8_WAIT_L(0); PG8_BAR; PG8_MMA(1, 0, At, B0); PG8_MMA(1, 1, At, B1); PG8_BAR; PG8_SCHED;
            } else {
            PG8_LDB(B0, 0, 0); PG8_SCHED; PG8_LDA(At, 0, 0); PG8_STAGE(PG8_SA(1, 1), a1 + hstep, voffA);
            PG8_WAIT_L(8); PG8_BAR; PG8_WAIT_L(0); PG8_MMA(0, 0, At, B0); PG8_BAR; PG8_SCHED;
            PG8_LDB(B1, 0, 1); PG8_STAGE(PG8_SB(0, 0), b2, voffB);
            PG8_BAR; PG8_WAIT_L(0); PG8_MMA(0, 1, At, B1); PG8_BAR;
            PG8_LDA(At, 0, 1); PG8_STAGE(PG8_SA(0, 0), a2, voffA);
            PG8_BAR; PG8_WAIT_L(0); PG8_MMA(1, 0, At, B0); PG8_BAR; PG8_SCHED;
            PG8_STAGE(PG8_SB(0, 1), b2 + hstep, voffB);
            PG8_WAIT_V(6); PG8_BAR; PG8_MMA(1, 1, At, B1); PG8_BAR;
            PG8_LDB(B0, 1, 0); PG8_SCHED; PG8_LDA(At, 1, 0); PG8_STAGE(PG8_SA(0, 1), a2 + hstep, voffA);
            PG8_WAIT_L(8); PG8_BAR; PG8_WAIT_L(0); PG8_MMA(0, 0, At, B0); PG8_BAR; PG8_SCHED;
            PG8_LDB(B1, 1, 1); PG8_STAGE(PG8_SB(1, 0), b3, voffB);
            PG8_BAR; PG8_WAIT_L(0); PG8_MMA(0, 1, At, B1); PG8_BAR;
            PG8_LDA(At, 1, 1); PG8_STAGE(PG8_SA(1, 0), a3, voffA);
            PG8_BAR; PG8_WAIT_L(0); PG8_MMA(1, 0, At, B0); PG8_BAR; PG8_SCHED;
            PG8_STAGE(PG8_SB(1, 1), b3 + hstep, voffB);
            PG8_WAIT_V(6); PG8_BAR; PG8_MMA(1, 1, At, B1); PG8_BAR;
            }
        }
        if constexpr (ALIGN_EPI) { if (wr == 0) PG8_BAR; }
        if constexpr (!Epi::AFTER_DRAIN) { E(acc, cur, wr, wc, fr, fq); S.done(cur); }
        if (!has_next) break;
#pragma unroll
        for (int a = 0; a < 2; ++a)
#pragma unroll
            for (int b = 0; b < 2; ++b)
#pragma unroll
                for (int m = 0; m < 4; ++m)
#pragma unroll
                    for (int n = 0; n < 2; ++n) acc[a][b][m][n] = (f32x4){0.f, 0.f, 0.f, 0.f};
        cur = nxt; cA = nA; cB = nB; ++ui;
        if constexpr (ALIGN_EPI) { if (wr == 1) PG8_BAR; }
    }
    PG8_WAIT_V(0);
    if constexpr (!ALIGN_EPI) { if (wr == 0) PG8_BAR; }
    PG8_BAR;
    if constexpr (Epi::AFTER_DRAIN) { E.fused(acc, cur, wr, wc, fr, fq, lds, wid, lane); S.done(cur); }
#undef PG8_SA
#undef PG8_SB
#undef PG8_STAGE
#undef PG8_LDA
#undef PG8_LDB
#undef PG8_MMA
#undef PG8_WAIT_V
#undef PG8_WAIT_L
#undef PG8_BAR
#undef PG8_SCHED
}
}
#ifndef PG8_SP2
#define PG8_SP2 true
#endif
#ifndef PG8_ALIGN
#define PG8_ALIGN true
#endif
constexpr int NWAVES = 8;
constexpr int D = 1024, NB = 8, SEQ = 2048, CTXL = 256, DEPTH = 2, GW = 64;
constexpr int MLAT = NB * SEQ, MCTX = NB * CTXL, MALL = MLAT + MCTX;
constexpr int PW = 2560, FF = 2816, NMOD = 6 * D;
constexpr int C_AQ = 0, C_AK = 384, C_AV = 512, C_BQ = 640, C_BK = 896, C_BV = 1152, C_CQ = 1408, C_CK = 1792, C_CV = 2176;
constexpr int M_A = 0, M_B = 384, M_C = 640;
constexpr float LN_EPS = 1e-5f, LOG2E = 1.4426950408889634f, ALPHA = 1.4142135623730951f;
enum { I_X = 0, I_C, I_CTX, I_CCTX, I_WADA, I_BADA, I_WIN, I_WO, I_SINK, I_LQ1, I_LK1, I_LQ2, I_LK2, I_SUBG, I_NAB, I_LN1G, I_LN1B, I_WFI, I_WFO, I_LN2G, I_LN2B, N_IN };
constexpr size_t MiB = 1u << 20;
constexpr size_t WS_CTL = 0, CTL_ZERO_BYTES = 1 * MiB;
constexpr size_t WS_MOD = 1 * MiB;
constexpr size_t WS_TAB = WS_MOD + 512 * 1024;
constexpr size_t TAB_ROPEA = 0, TAB_ROPEB = 2048, TAB_SCAL = 3072, TAB_CSCALE = 3136;
constexpr size_t WS_W = 2 * MiB;
constexpr size_t W_LAYER = 23 * MiB + 512 * 1024, W_IN = 0, W_O = 5 * MiB, W_FI = 7 * MiB, W_FO = 18 * MiB;
constexpr size_t WS_HA = 49 * MiB;
constexpr size_t WS_RC = 85 * MiB;
constexpr size_t WS_OB = 93 * MiB;
constexpr size_t WS_P = 111 * MiB;
constexpr size_t WS_MIX = 201 * MiB;
constexpr size_t WS_HID = 111 * MiB;
constexpr size_t WS_END = 237 * MiB;
static_assert(WS_W + 2 * W_LAYER <= WS_HA && WS_HA + (size_t)MALL * D * 2 <= WS_RC && WS_RC + (size_t)MCTX * D * 4 <= WS_OB && WS_OB + (size_t)MALL * 512 * 2 <= WS_P && WS_P + (size_t)MALL * PW * 2 <= WS_MIX && WS_MIX + (size_t)MALL * D * 2 <= WS_END && WS_HID + (size_t)MALL * FF * 2 <= WS_END, "d_ws map");
constexpr int CW_TMO = 0, CW_CODE = 1, CW_BAR = 4096;
constexpr int RING_OFF = 0, RING_BYTES = 131072;
constexpr int LDSCTL_OFF = RING_BYTES, MISC_OFF = LDSCTL_OFF + 320;
constexpr int LDS_BYTES = 147456;
static_assert(MISC_OFF + 128 <= LDS_BYTES, "LDS map");

#define GAS __attribute__((address_space(1)))
#define LAS __attribute__((address_space(3)))
typedef unsigned short bf16;
typedef unsigned v4u __attribute__((ext_vector_type(4)));
typedef float f32x4 __attribute__((ext_vector_type(4)));
typedef short bf16x8 __attribute__((ext_vector_type(8)));
typedef GAS unsigned gu32;
typedef GAS unsigned long long gu64;
#define RLX_AGENT __ATOMIC_RELAXED, __HIP_MEMORY_SCOPE_AGENT
#define LDS_WAIT() asm volatile("s_waitcnt lgkmcnt(0)" ::: "memory")
#define VM_WAIT() asm volatile("s_waitcnt vmcnt(0)" ::: "memory")
__device__ __forceinline__ unsigned long long rt() { return __builtin_amdgcn_s_memrealtime(); }
__device__ __forceinline__ unsigned f2bf(float f) { unsigned u = __builtin_bit_cast(unsigned, f); return (u + 0x7fffu + ((u >> 16) & 1u)) >> 16; }
__device__ __forceinline__ unsigned pk2(float lo, float hi) { return f2bf(lo) | (f2bf(hi) << 16); }

#define XB_TMO      128
#define XB_XCNT(j)  (256  + 64 * (j))
#define XB_XSUB(j)  (1280 + 64 * (j))
#define XB_XGEN(j)  (2304 + 64 * (j))
#define XB_TOP      3328
#define XB_TOPGEN   3392
#define XCD_BAR_WORDS 3456
#define XB_SPIN_CAP (1u << 18)

__device__ __forceinline__ unsigned xb_ld(unsigned* p)              { return __hip_atomic_load(p, __ATOMIC_RELAXED, __HIP_MEMORY_SCOPE_AGENT); }
__device__ __forceinline__ unsigned xb_add(unsigned* p, unsigned v) { return __hip_atomic_fetch_add(p, v, __ATOMIC_RELAXED, __HIP_MEMORY_SCOPE_AGENT); }
__device__ __forceinline__ unsigned xb_xcc_id() { return (unsigned)__builtin_amdgcn_s_getreg((3 << 11) | 20) & 0xFu; }
#define XB_SPIN(cond, bar) do { unsigned _sp = 0; while (cond) { __builtin_amdgcn_s_sleep(1); \
    if ((++_sp & 255u) == 0u) { if (xb_ld(&(bar)[XB_TMO])) break; if (_sp > XB_SPIN_CAP) { atomicAdd(&(bar)[XB_TMO], 1u); break; } } } } while (0)

struct XcdBarrier {
    unsigned* bar; unsigned x;
    volatile LAS unsigned* st;
};

__device__ __forceinline__ XcdBarrier xcd_barrier_post(unsigned* bar, volatile LAS unsigned* st) {
    XcdBarrier b; b.bar = bar; b.x = xb_xcc_id(); b.st = st;
    if (threadIdx.x == 0) (void)xb_add(&bar[XB_XCNT(b.x)], 1u);
    return b;
}
__device__ __forceinline__ void xcd_barrier_complete(unsigned* bar, unsigned x, unsigned& nloc, unsigned& nx) {
    const unsigned G = gridDim.x * gridDim.y * gridDim.z;
    unsigned sum, cnt, mine, sp = 0u;
    for (;;) {
        sum = 0u; cnt = 0u; mine = 0u;
#pragma unroll
        for (unsigned j = 0; j < 16; ++j) { const unsigned c = xb_ld(&bar[XB_XCNT(j)]); sum += c; cnt += (c > 0u) ? 1u : 0u; mine = (j == x) ? c : mine; }
        if (sum == G) break;
        __builtin_amdgcn_s_sleep(1);
        if ((++sp & 255u) == 0u) { if (xb_ld(&bar[XB_TMO])) break; if (sp > XB_SPIN_CAP) { atomicAdd(&bar[XB_TMO], 1u); break; } }
    }
    nloc = mine > 0u ? mine : 1u; nx = cnt > 0u ? cnt : 1u;
}

__device__ __forceinline__ void xcd_barrier(const XcdBarrier& b) {
    asm volatile("s_waitcnt vmcnt(0)" ::: "memory");
    __syncthreads();
    if (threadIdx.x == 0) {
        unsigned* bar = b.bar;
        __builtin_amdgcn_s_waitcnt(0);
        unsigned nloc = b.st[0], nx = b.st[1];
        if (nloc == 0u) { xcd_barrier_complete(bar, b.x, nloc, nx); b.st[0] = nloc; b.st[1] = nx; }
        const unsigned old = xb_add(&bar[XB_XSUB(b.x)], 1u);
        const unsigned gen = old / nloc;
        if (old + 1u == (gen + 1u) * nloc) {
            __builtin_amdgcn_fence(__ATOMIC_RELEASE, "agent");
            asm volatile("s_waitcnt vmcnt(0)" ::: "memory");
            const unsigned og = xb_add(&bar[XB_TOP], 1u);
            const unsigned tg = og / nx;
            if (og + 1u == (tg + 1u) * nx) xb_add(&bar[XB_TOPGEN], 1u);
            else XB_SPIN(xb_ld(&bar[XB_TOPGEN]) == tg, bar);
            __builtin_amdgcn_fence(__ATOMIC_ACQUIRE, "agent");
            xb_add(&bar[XB_XGEN(b.x)], 1u);
            asm volatile("s_waitcnt vmcnt(0)" ::: "memory");
        } else {
            XB_SPIN(xb_ld(&bar[XB_XGEN(b.x)]) == gen, bar);
            __builtin_amdgcn_fence(__ATOMIC_ACQUIRE, "agent");
            asm volatile("s_waitcnt vmcnt(0)" ::: "memory");
        }
    }
    __syncthreads();
}

struct Frame {
    LAS unsigned char* lds;
    volatile LAS unsigned* MISC;
    gu32* ctl;
    int tid, lane, wave;
    int vcu, G;
    const float* in[N_IN]; float* out; unsigned char* ws;
};
__device__ __forceinline__ float bf2f(unsigned short u) { return __uint_as_float((unsigned)u << 16); }
__device__ __forceinline__ float wave_sum(float v) {
#pragma unroll
    for (int o = 1; o < 64; o <<= 1) v += __shfl_xor(v, o);
    return v;
}
__device__ __forceinline__ float wave_max(float v) {
#pragma unroll
    for (int o = 1; o < 64; o <<= 1) v = fmaxf(v, __shfl_xor(v, o));
    return v;
}
template <int MODE>
__device__ __forceinline__ void p0_transpose_item(const float* W, int K, int N, bf16* WT, LAS float* scr, int item, int lane) {
    const int nblk = N / 32, kb = item / nblk, nb = item % nblk, k0 = 64 * kb, n0 = 32 * nb;
#pragma unroll 8
    for (int i = 0; i < 32; ++i) { const int kk = 2 * i + (lane >> 5); scr[kk * 33 + (lane & 31)] = W[(size_t)(k0 + kk) * N + n0 + (lane & 31)]; }
    LDS_WAIT(); asm volatile("" ::: "memory");
    const int c = lane & 7;
    int r0 = n0;
    if (MODE == 1) { const int bj = n0 / FF, rem = n0 - bj * FF; r0 = 256 * (rem >> 7) + 128 * bj + (rem & 127); }
#pragma unroll
    for (int j = 0; j < 4; ++j) { const int n = (lane >> 3) + 8 * j; const LAS float* s = scr + (8 * c) * 33 + n;
        v4u o; o.x = pk2(s[0 * 33], s[1 * 33]); o.y = pk2(s[2 * 33], s[3 * 33]); o.z = pk2(s[4 * 33], s[5 * 33]); o.w = pk2(s[6 * 33], s[7 * 33]);
        *(GAS v4u*)(WT + (size_t)(r0 + n) * K + k0 + 8 * c) = o; }
    LDS_WAIT(); asm volatile("" ::: "memory");
}
__device__ __forceinline__ float silu_f(float x) { return x / (1.0f + expf(-x)); }

__device__ __forceinline__ void p0a_prologue(Frame& F) {
    int tid_ = F.tid; asm volatile("" : "+v"(tid_) :: "memory"); const int P_tid = tid_, P_lane = tid_ & 63, P_wave = __builtin_amdgcn_readfirstlane(tid_ >> 6); (void)P_tid; (void)P_lane; (void)P_wave;

    float* MOD = (float*)(F.ws + WS_MOD); float* TAB = (float*)(F.ws + WS_TAB);
    {
        LAS float* sv = (LAS float*)(F.lds);
        LAS float* red = (LAS float*)(F.lds + 9 * 1024 * 4);
        for (int i = P_tid; i < 9 * 1024; i += NWAVES * 64) { const int bi = i >> 10, k = i & 1023; const float v = bi < 8 ? F.in[I_C][bi * 1024 + k] : F.in[I_CCTX][k]; sv[i] = silu_f(v); }
        __syncthreads();
        for (int it = F.vcu; it < 2 * 96; it += F.G) {
            const int l = it / 96, n0 = (it % 96) * 64;
            const float* W = F.in[I_WADA] + (size_t)l * D * NMOD + n0 + P_lane;
            float acc[9];
#pragma unroll
            for (int b = 0; b < 9; ++b) acc[b] = 0.f;
            const int kbeg = P_wave * 128;
#pragma unroll 8
            for (int k = kbeg; k < kbeg + 128; ++k) { const float w = W[(size_t)k * NMOD];
#pragma unroll
                for (int b = 0; b < 9; ++b) acc[b] += sv[b * 1024 + k] * w; }
#pragma unroll
            for (int b = 0; b < 9; ++b) red[(P_wave * 9 + b) * 64 + P_lane] = acc[b];
            __syncthreads();
            for (int i = P_tid; i < 9 * 64; i += NWAVES * 64) { const int b = i >> 6, n = i & 63; float s = 0.f;
#pragma unroll
                for (int w = 0; w < 8; ++w) s += red[(w * 9 + b) * 64 + n];
                MOD[((size_t)l * 9 + b) * NMOD + n0 + n] = s + F.in[I_BADA][l * NMOD + n0 + n]; }
            __syncthreads();
        }
    }
    if (F.vcu == F.G - 1) {
        for (int i = P_tid; i < 64 * 16; i += NWAVES * 64) { const int pos = i >> 4, f = i & 15; const float ang = (float)pos * exp2f(-(float)f * (13.287712379549449f / 16.0f)); TAB[TAB_ROPEA + 2 * i] = cosf(ang); TAB[TAB_ROPEA + 2 * i + 1] = sinf(ang); }
        for (int i = P_tid; i < 64 * 8; i += NWAVES * 64) { const int pos = i >> 3, f = i & 7; const float ang = (float)pos * exp2f(-(float)f * (13.287712379549449f / 8.0f)); TAB[TAB_ROPEB + 2 * i] = cosf(ang); TAB[TAB_ROPEB + 2 * i + 1] = sinf(ang); }
        if (P_wave == 0) {
            for (int l = 0; l < DEPTH; ++l) {
                float a = P_lane < 32 ? F.in[I_LQ1][l * 32 + P_lane] * F.in[I_LK1][l * 32 + P_lane] : 0.f;
                float b = P_lane < 32 ? F.in[I_LQ2][l * 32 + P_lane] * F.in[I_LK2][l * 32 + P_lane] : 0.f;
                a = wave_sum(a); b = wave_sum(b);
                const float lam_init = 0.8f - 0.6f * expf(-0.3f * (float)l);
                if (P_lane == 0) { TAB[TAB_SCAL + 4 * l] = expf(a) - expf(b) + lam_init; TAB[TAB_SCAL + 4 * l + 1] = 1.0f - lam_init; }
            }
        }
        for (int c = P_tid; c < PW; c += NWAVES * 64) {
            float s = 1.0f;
            if (c < C_AK || (c >= C_CQ && c < C_CK)) s = 0.125f * LOG2E;
            else if (c >= C_BQ && c < C_BK) s = 0.17677669529663687f * LOG2E;
            TAB[TAB_CSCALE + c] = s;
        }
    }
    __syncthreads();
    LAS float* scr = (LAS float*)(F.lds + RING_OFF + P_wave * 16384);
    const int gw = F.vcu * NWAVES + P_wave, NGW = F.G * NWAVES;
    constexpr int I_1 = (D / 64) * (PW / 32), I_2 = (D / 64) * (D / 32), I_3 = (D / 64) * (2 * FF / 32), I_4 = (FF / 64) * (D / 32), I_L = I_1 + I_2 + I_3 + I_4;
    for (int it = gw; it < DEPTH * I_L; it += NGW) {
        const int l = it / I_L; int r = it % I_L;
        unsigned char* wl = F.ws + WS_W + (size_t)l * W_LAYER;
        if (r < I_1) { p0_transpose_item<0>(F.in[I_WIN] + (size_t)l * D * PW, D, PW, (bf16*)(wl + W_IN), scr, r, P_lane); continue; } r -= I_1;
        if (r < I_2) { p0_transpose_item<0>(F.in[I_WO] + (size_t)l * D * D, D, D, (bf16*)(wl + W_O), scr, r, P_lane); continue; } r -= I_2;
        if (r < I_3) { p0_transpose_item<1>(F.in[I_WFI] + (size_t)l * D * 2 * FF, D, 2 * FF, (bf16*)(wl + W_FI), scr, r, P_lane); continue; } r -= I_3;
        p0_transpose_item<0>(F.in[I_WFO] + (size_t)l * FF * D, FF, D, (bf16*)(wl + W_FO), scr, r, P_lane);
    }
}
__device__ __forceinline__ float* res_row(Frame& F, int r) { return r < MLAT ? F.out + (size_t)r * D : (float*)(F.ws + WS_RC) + (size_t)(r - MLAT) * D; }
__device__ __forceinline__ const float* in_row(Frame& F, int r) { return r < MLAT ? F.in[I_X] + (size_t)r * D : F.in[I_CTX] + (size_t)(r - MLAT) * D; }
__device__ __forceinline__ int row_bi(int r) { return r < MLAT ? (r >> 11) : 8; }
__device__ __forceinline__ void p0b_modulate(Frame& F) {
    int tid_ = F.tid; asm volatile("" : "+v"(tid_) :: "memory"); const int P_tid = tid_, P_lane = tid_ & 63, P_wave = __builtin_amdgcn_readfirstlane(tid_ >> 6); (void)P_tid; (void)P_lane; (void)P_wave;

    const float* MOD = (const float*)(F.ws + WS_MOD); bf16* HA = (bf16*)(F.ws + WS_HA);
    const int gw = F.vcu * NWAVES + P_wave, NGW = F.G * NWAVES;
    for (int r = gw; r < MALL; r += NGW) {
        const GAS f32x4* xr = (const GAS f32x4*)in_row(F, r) + P_lane; const float* md = MOD + (size_t)row_bi(r) * NMOD;
        GAS unsigned long long* o8 = (GAS unsigned long long*)(HA + (size_t)r * D) + P_lane;
#pragma unroll
        for (int j = 0; j < 4; ++j) { const f32x4 v = xr[64 * j]; const int c = 4 * P_lane + 256 * j; const f32x4 sh = *(const f32x4*)(md + c), sc = *(const f32x4*)(md + D + c);
            const f32x4 h = v * (sc + 1.0f) + sh; o8[64 * j] = (unsigned long long)pk2(h.x, h.y) | ((unsigned long long)pk2(h.z, h.w) << 32); }
    }
}
__device__ __forceinline__ void ln_pass(Frame& F, int nrows, const float* lng, const float* lnb, const float* mod  , int sh_off) {
    int tid_ = F.tid; asm volatile("" : "+v"(tid_) :: "memory"); const int P_tid = tid_, P_lane = tid_ & 63, P_wave = __builtin_amdgcn_readfirstlane(tid_ >> 6); (void)P_tid; (void)P_lane; (void)P_wave;

    bf16* HA = (bf16*)(F.ws + WS_HA);
    const int gw = F.vcu * NWAVES + P_wave, NGW = F.G * NWAVES;
    for (int r = gw; r < nrows; r += NGW) {
        float* rr = res_row(F, r); GAS f32x4* xr = (GAS f32x4*)rr + P_lane;
        f32x4 v[4]; float s = 0.f;
#pragma unroll
        for (int j = 0; j < 4; ++j) { v[j] = xr[64 * j]; s += (v[j].x + v[j].y) + (v[j].z + v[j].w); }
        const float mean = wave_sum(s) * (1.f / D); float s2 = 0.f;
#pragma unroll
        for (int j = 0; j < 4; ++j) { v[j] = v[j] - mean; s2 += (v[j].x * v[j].x + v[j].y * v[j].y) + (v[j].z * v[j].z + v[j].w * v[j].w); }
        const float rstd = 1.f / sqrtf(wave_sum(s2) * (1.f / D) + LN_EPS);
        const float* md = mod ? mod + (size_t)row_bi(r) * NMOD + sh_off : nullptr;
        GAS unsigned long long* o8 = (GAS unsigned long long*)(HA + (size_t)r * D) + P_lane;
#pragma unroll
        for (int j = 0; j < 4; ++j) { const int c = 4 * P_lane + 256 * j; const f32x4 g = *(const f32x4*)(lng + c), b = *(const f32x4*)(lnb + c);
            const f32x4 y = v[j] * rstd * g + b; xr[64 * j] = y;
            if (md) { const f32x4 sh = *(const f32x4*)(md + c), sc = *(const f32x4*)(md + D + c); const f32x4 h = y * (sc + 1.0f) + sh;
                o8[64 * j] = (unsigned long long)pk2(h.x, h.y) | ((unsigned long long)pk2(h.z, h.w) << 32); } }
    }
}
__device__ __forceinline__ void rope_pass(Frame& F) {
    int tid_ = F.tid; asm volatile("" : "+v"(tid_) :: "memory"); const int P_tid = tid_, P_lane = tid_ & 63, P_wave = __builtin_amdgcn_readfirstlane(tid_ >> 6); (void)P_tid; (void)P_lane; (void)P_wave;

    bf16* P = (bf16*)(F.ws + WS_P); const float* TAB = (const float*)(F.ws + WS_TAB);
    const int gt = F.vcu * NWAVES * 64 + P_tid, NT = F.G * NWAVES * 64;
    for (long idx = gt; idx < (long)MLAT * 512; idx += NT) {
        const int r = (int)(idx >> 9), p = (int)(idx & 511); const int t = r & (SEQ - 1), prow = t >> 6, pcol = t & 63;
        int c1, c2, pos, fi; bool isA;
        if (p < 256) { const int h = p >> 5, q = p & 31; const int hb = (h < 6 ? C_AQ + h * 64 : C_AK + (h - 6) * 64); isA = true;
            if (q < 16) { c1 = hb + q; c2 = hb + 16 + q; pos = prow; fi = q; } else { c1 = hb + 32 + (q - 16); c2 = hb + 48 + (q - 16); pos = pcol; fi = q - 16; } }
        else { const int pp = p - 256, v = pp >> 4, q = pp & 15; const int vb = (v < 8 ? C_BQ + v * 32 : C_BK + (v - 8) * 32); isA = false;
            if (q < 8) { c1 = vb + q; c2 = vb + 8 + q; pos = prow; fi = q; } else { c1 = vb + 16 + (q - 8); c2 = vb + 24 + (q - 8); pos = pcol; fi = q - 8; } }
        const float cs = isA ? TAB[TAB_ROPEA + 2 * (pos * 16 + fi)] : TAB[TAB_ROPEB + 2 * (pos * 8 + fi)];
        const float sn = isA ? TAB[TAB_ROPEA + 2 * (pos * 16 + fi) + 1] : TAB[TAB_ROPEB + 2 * (pos * 8 + fi) + 1];
        bf16* row = P + (size_t)r * PW; const float x1 = bf2f(row[c1]), x2 = bf2f(row[c2]);
        row[c1] = (bf16)f2bf(x1 * cs - x2 * sn); row[c2] = (bf16)f2bf(x2 * cs + x1 * sn);
    }
}

namespace naive {
constexpr int MAXK = 2304;
__device__ __forceinline__ void load64(const bf16* p, float* v) {
#pragma unroll
    for (int i = 0; i < 8; ++i) { const v4u w = *(const v4u*)(p + 8 * i);
        v[8 * i + 0] = __uint_as_float(w.x << 16); v[8 * i + 1] = __uint_as_float(w.x & 0xffff0000u); v[8 * i + 2] = __uint_as_float(w.y << 16); v[8 * i + 3] = __uint_as_float(w.y & 0xffff0000u);
        v[8 * i + 4] = __uint_as_float(w.z << 16); v[8 * i + 5] = __uint_as_float(w.z & 0xffff0000u); v[8 * i + 6] = __uint_as_float(w.w << 16); v[8 * i + 7] = __uint_as_float(w.w & 0xffff0000u); }
}
template <int VAR> __device__ __forceinline__ void attn_item(int item, int lane, LAS float* s1, LAS float* s2, const bf16* __restrict__ P, bf16* __restrict__ MIX, const float* __restrict__ sinkv, const float* __restrict__ nab, const float* __restrict__ scal, const float* __restrict__ subg) {
    constexpr bool LAT = (VAR % 2) == 0; constexpr int KIND = VAR / 2; constexpr int NH = (KIND == 1) ? 4 : 6;
    const int ri = item / NH, h = item % NH;
    const int row = LAT ? ri : MLAT + ri; const int b = LAT ? (ri >> 11) : (ri >> 8); const int t = ri & (SEQ - 1);
    const int qcol = KIND == 0 ? C_AQ + h * 64 : (KIND == 1 ? C_BQ + h * 64 : C_CQ + h * 64);
    const int kcol = KIND == 0 ? C_AK + (h / 3) * 64 : (KIND == 1 ? C_BK + h * 64 : C_CK + h * 64);
    const int vcol = KIND == 0 ? C_AV + (h / 3) * 64 : (KIND == 1 ? C_BV + h * 64 : C_CV + h * 64);
    float q[64]; load64(P + (size_t)row * PW + qcol, q);
    int nloc = 0, lo = 0, rs = 0, cs = 0; const int qr = t >> 6, qw = t & 63;
    if (LAT) {
        if (KIND == 0) { lo = max(0, t - 128); const int hi = min(SEQ - 1, t + 128); nloc = hi - lo + 1; }
        else if (KIND == 1) { nloc = SEQ; }
        else { rs = min(max(qr - 4, 0), 24); cs = min(max(qw - 8, 0), 48); nloc = 128; }
    }
    const int nk = nloc + CTXL;
    float m1 = -INFINITY, m2 = -INFINITY;
    for (int j = lane; j < nk; j += 64) {
        int krow; float bias = 0.f;
        if (j < nloc) {
            int tk;
            if (KIND == 0) tk = lo + j; else if (KIND == 1) tk = j; else { const int kr = rs + (j >> 4), kc = cs + (j & 15); tk = kr * 64 + kc;
                const int dr = kr - qr + 7, dc = min(max(kc - qw, -15), 15) + 15; bias = nab[(h * 15 + dr) * 31 + dc] * LOG2E; }
            krow = b * SEQ + tk;
        } else krow = MLAT + b * CTXL + (j - nloc);
        float kv[64]; load64(P + (size_t)krow * PW + kcol, kv);
        if (KIND == 1) { float d1 = 0.f, d2 = 0.f;
#pragma unroll
            for (int d = 0; d < 32; ++d) { d1 += q[d] * kv[d]; d2 += q[32 + d] * kv[32 + d]; }
            s1[j] = d1; s2[j] = d2; m1 = fmaxf(m1, d1); m2 = fmaxf(m2, d2);
        } else { float d1 = 0.f;
#pragma unroll
            for (int d = 0; d < 64; ++d) d1 += q[d] * kv[d];
            d1 += bias; s1[j] = d1; m1 = fmaxf(m1, d1); }
    }
    float sk = -INFINITY; if (KIND == 0) { sk = sinkv[h] * LOG2E; m1 = fmaxf(m1, sk); }
    m1 = wave_max(m1); if (KIND == 1) m2 = wave_max(m2);
    float l1 = 0.f, l2 = 0.f;
    for (int j = lane; j < nk; j += 64) { const float p = exp2f(s1[j] - m1); s1[j] = p; l1 += p; if (KIND == 1) { const float p2 = exp2f(s2[j] - m2); s2[j] = p2; l2 += p2; } }
    l1 = wave_sum(l1); if (KIND == 1) l2 = wave_sum(l2); if (KIND == 0) l1 += exp2f(sk - m1);
    __builtin_amdgcn_s_waitcnt(0xC07F); asm volatile("" ::: "memory");
    const float lam = (KIND == 1) ? scal[0] : 0.f;
    const float i1 = 1.0f / l1, i2 = (KIND == 1) ? lam / l2 : 0.f;
    float o = 0.f;
    for (int j = 0; j < nk; ++j) {
        int krow;
        if (j < nloc) { int tk; if (KIND == 0) tk = lo + j; else if (KIND == 1) tk = j; else tk = (rs + (j >> 4)) * 64 + cs + (j & 15); krow = b * SEQ + tk; }
        else krow = MLAT + b * CTXL + (j - nloc);
        const float w = (KIND == 1) ? (s1[j] * i1 - s2[j] * i2) : s1[j] * i1;
        o += w * bf2f(P[(size_t)krow * PW + vcol + lane]);
    }
    if (KIND == 1) { const float ms = wave_sum(o * o) * (1.0f / 64.0f); o = o * (1.0f / sqrtf(ms + LN_EPS)) * subg[lane] * scal[1]; }
    const int mcol = KIND == 0 ? M_A + h * 64 : (KIND == 1 ? M_B + h * 64 : M_C + h * 64);
    MIX[(size_t)row * D + mcol + lane] = (bf16)f2bf(o);
}
template <int VAR> __device__ __forceinline__ int n_items() { return ((VAR % 2) == 0 ? MLAT : MCTX) * ((VAR / 2) == 1 ? 4 : 6); }
template <int VAR> __device__ __forceinline__ void attn_phase(LAS unsigned char* lds, int vcu, int G, const bf16* P, bf16* MIX, const float* sinkv, const float* nab, const float* scal, const float* subg) {
    int tid_ = threadIdx.x; asm volatile("" : "+v"(tid_) :: "memory"); const int lane = tid_ & 63, wave = __builtin_amdgcn_readfirstlane(tid_ >> 6);
    constexpr bool TWO = (VAR / 2) == 1; constexpr int WPB = TWO ? 4 : 8;
    if (wave >= WPB) return;
    LAS float* s1 = (LAS float*)(lds + wave * (TWO ? 32768 : 16384)); LAS float* s2 = s1 + 4096;
    for (int item = vcu * WPB + wave; item < n_items<VAR>(); item += G * WPB) attn_item<VAR>(item, lane, s1, s2, P, MIX, sinkv, nab, scal, subg);
}
}
namespace att {

using bf16=__hip_bfloat16;
using bf16x8=__attribute__((ext_vector_type(8)))short;
using s16x4=__attribute__((ext_vector_type(4)))short;
using f32x16=__attribute__((ext_vector_type(16)))float;
using u32x4=__attribute__((ext_vector_type(4)))unsigned;
constexpr int NW=8,QBLK=32,QB=QBLK*NW,KVBLK=64;
__device__ __forceinline__ int crow(int r,int hi){return (r&3)+8*(r>>2)+4*hi;}
#define SBAR() __builtin_amdgcn_sched_barrier(0)
constexpr int NSLOT=3, SLOTB=8192;
constexpr int LDS_K=0, LDS_V=NSLOT*SLOTB, LDS_WS=2*NSLOT*SLOTB, LDS_OST=LDS_WS+NW*64*4, LDS_BIAS=LDS_OST+NW*8192, LDS_BYTES=LDS_BIAS+4096;
__device__ __forceinline__ void glds16(const void*gsrc,unsigned lds_dst){unsigned keep;
  asm volatile("s_mov_b32 %0, m0\n\ts_mov_b32 m0, %2\n\ts_nop 0\n\tglobal_load_lds_dwordx4 %1, off\n\ts_mov_b32 m0, %0":"=&s"(keep):"v"(gsrc),"s"(lds_dst):"memory");}
__device__ __forceinline__ float max3f(float a,float b,float c){float r;asm("v_max3_f32 %0, %1, %2, %3":"=v"(r):"v"(a),"v"(b),"v"(c));return r;}
__device__ __forceinline__ float max2f(float a,float b){float r;asm("v_max_f32_e32 %0, %1, %2":"=v"(r):"v"(a),"v"(b));return r;}
__device__ __forceinline__ float fadd_s(float a,float b){float r;asm("v_add_f32_e32 %0, %1, %2":"=v"(r):"v"(a),"v"(b));return r;}
__device__ __forceinline__ float fsub_s(float a,float b){float r;asm("v_sub_f32_e32 %0, %1, %2":"=v"(r):"v"(a),"v"(b));return r;}
typedef float f32x2_t __attribute__((ext_vector_type(2))); typedef __bf16 bf16x2_t __attribute__((ext_vector_type(2)));
__device__ __forceinline__ unsigned cvtpk_s(float lo,float hi){f32x2_t v={lo,hi};bf16x2_t b=__builtin_convertvector(v,bf16x2_t);return __builtin_bit_cast(unsigned,b);}
#define WAIT_BAR(N) asm volatile("s_waitcnt vmcnt(" #N ") lgkmcnt(0)\n\ts_barrier":::"memory")

__device__ __forceinline__ void qkt(f32x16&p0,f32x16&p1,const char*Kslot,const bf16x8*qr,const f32x16&negm,int r32,int hi){
  const char*kb=Kslot+hi*1024+r32*16;
  #pragma unroll
  for(int d0=0;d0<4;++d0){
    const bf16x8 b0=*reinterpret_cast<const bf16x8*>(kb+d0*2048);
    const bf16x8 b1=*reinterpret_cast<const bf16x8*>(kb+d0*2048+512);
    if(d0==0){p0=__builtin_amdgcn_mfma_f32_32x32x16_bf16(b0,qr[0],negm,0,0,0);p1=__builtin_amdgcn_mfma_f32_32x32x16_bf16(b1,qr[0],negm,0,0,0);}
    else{p0=__builtin_amdgcn_mfma_f32_32x32x16_bf16(b0,qr[d0],p0,0,0,0);p1=__builtin_amdgcn_mfma_f32_32x32x16_bf16(b1,qr[d0],p1,0,0,0);}}
}
typedef __attribute__((address_space(3))) const char* lds_cptr;
typedef short v4i16_t __attribute__((ext_vector_type(4)));
__device__ __forceinline__ void kload8(bf16x8*kf,lds_cptr kp){
  kf[0]=*(const __attribute__((address_space(3))) bf16x8*)(kp);      kf[1]=*(const __attribute__((address_space(3))) bf16x8*)(kp+512);
  kf[2]=*(const __attribute__((address_space(3))) bf16x8*)(kp+2048); kf[3]=*(const __attribute__((address_space(3))) bf16x8*)(kp+2560);
  kf[4]=*(const __attribute__((address_space(3))) bf16x8*)(kp+4096); kf[5]=*(const __attribute__((address_space(3))) bf16x8*)(kp+4608);
  kf[6]=*(const __attribute__((address_space(3))) bf16x8*)(kp+6144); kf[7]=*(const __attribute__((address_space(3))) bf16x8*)(kp+6656);
}
__device__ __forceinline__ void kload2(bf16x8*kf,lds_cptr kp,int j){ kf[2*j]=*(const __attribute__((address_space(3))) bf16x8*)(kp+j*2048); kf[2*j+1]=*(const __attribute__((address_space(3))) bf16x8*)(kp+j*2048+512); }
__device__ __forceinline__ s16x4 vtr(lds_cptr p){ return __builtin_bit_cast(s16x4,__builtin_amdgcn_ds_read_tr16_b64_v4i16((__attribute__((address_space(3))) v4i16_t*)p)); }
__device__ __forceinline__ float rowmax(const f32x16&p0,const f32x16&p1){
  float a=max3f(p0[0],p0[1],p1[0]),b=max3f(p0[2],p0[3],p1[1]);a=max3f(a,p1[2],p1[3]);
  #pragma unroll
  for(int r=4;r<16;r+=4){a=max3f(a,p0[r],p0[r+1]);b=max3f(b,p0[r+2],p0[r+3]);a=max3f(a,p1[r],p1[r+1]);b=max3f(b,p1[r+2],p1[r+3]);}
  const float m=max2f(a,b);
  auto rr=__builtin_amdgcn_permlane32_swap(__float_as_uint(m),__float_as_uint(m),false,false);
  return max2f(__uint_as_float(rr[0]),__uint_as_float(rr[1]));
}
__device__ __forceinline__ void pv(f32x16*o,int vb,bf16x8 pa0,bf16x8 pa1,bf16x8 pa2,bf16x8 pa3){
  #pragma unroll
  for(int d0=0;d0<2;++d0){s16x4 lo[4],hi[4];
    #pragma unroll
    for(int ks=0;ks<4;++ks){
      asm volatile("ds_read_b64_tr_b16 %0,%1 offset:%c2":"=&v"(lo[ks]):"v"(vb),"i"(d0*4096+ks*1024):"memory");
      asm volatile("ds_read_b64_tr_b16 %0,%1 offset:%c2":"=&v"(hi[ks]):"v"(vb),"i"(d0*4096+ks*1024+512):"memory");}
    asm volatile("s_waitcnt lgkmcnt(0)":::"memory");SBAR();
    #define PK(k) (bf16x8){lo[k][0],lo[k][1],lo[k][2],lo[k][3],hi[k][0],hi[k][1],hi[k][2],hi[k][3]}
    o[d0]=__builtin_amdgcn_mfma_f32_32x32x16_bf16(pa0,PK(0),o[d0],0,0,0);
    o[d0]=__builtin_amdgcn_mfma_f32_32x32x16_bf16(pa1,PK(1),o[d0],0,0,0);
    o[d0]=__builtin_amdgcn_mfma_f32_32x32x16_bf16(pa2,PK(2),o[d0],0,0,0);
    o[d0]=__builtin_amdgcn_mfma_f32_32x32x16_bf16(pa3,PK(3),o[d0],0,0,0);
    #undef PK
  }
}
struct UD {
  const bf16* q; const bf16* k; const bf16* v; bf16* o;
  int qrow0;
  int ctx_row0;
  int lat_row0;
  int lat_lo, lat_hi;
  int NT;
  int kpos0;
  int qpos0;
  bool lat;
  float sink2;
  float lam, onem;
  const float* subg;
  const float* nab;
};
template<int KIND,int THRL> __device__ __forceinline__ void attn_unit(const UD& ud,char*shm){
  int tid_=threadIdx.x; asm volatile("":"+v"(tid_)::"memory");
  const int tid=tid_,lane=tid&63,r32=lane&31,hi=lane>>5; const int wid=__builtin_amdgcn_readfirstlane(tid>>6);
  const unsigned lds0=(unsigned)(uintptr_t)shm;
  float*wsf=(float*)(shm+LDS_WS)+wid*64;
  const bf16*Qw=ud.q+(size_t)(ud.qrow0+wid*QBLK)*PW;
  const bf16*ksrc=ud.k+(size_t)lane*PW+wid*8;
  const bf16*vsrc=ud.v+(size_t)(16*(wid&3)+(lane>>2))*PW+(wid>>2)*32+(lane&3)*8;
  const unsigned kdst=lds0+LDS_K+wid*1024, vdst=lds0+LDS_V+wid*1024;
  #define TROW(t) ((t)<4 ? ud.ctx_row0+64*(t) : min(max(ud.lat_row0+64*((t)-4),ud.lat_lo),ud.lat_hi))
  #define DMA_K(t,slot) glds16(ksrc+(size_t)TROW(t)*PW,(unsigned)__builtin_amdgcn_readfirstlane(kdst+(slot)))
  #define DMA_V(t,slot) glds16(vsrc+(size_t)TROW(t)*PW,(unsigned)__builtin_amdgcn_readfirstlane(vdst+(slot)))
  const int vb0=(int)(lds0+LDS_V)+((lane>>4)&1)*32+(lane&3)*8+(4*hi+((lane&15)>>2))*64;
  const char*Kbase=shm+LDS_K; bf16x8 kf[8];
  const lds_cptr shm3=(lds_cptr)shm; const lds_cptr kp0=shm3+LDS_K+hi*1024+r32*16; const lds_cptr vp0=shm3+LDS_V+((lane>>4)&1)*32+(lane&3)*8+(4*hi+((lane&15)>>2))*64;
  const int NT=ud.NT;
  float*stgf=(float*)(shm+LDS_OST)+wid*2048;
  if(KIND==2){ float*bl=(float*)(shm+LDS_BIAS); if(ud.lat&&tid<465)bl[64+tid]=ud.nab[tid]*1.4426950408889634f; }
  constexpr int NPASS=(KIND==1)?2:1;
  #pragma unroll 1
  for(int pass=0;pass<NPASS;++pass){
  DMA_K(0,0);DMA_V(0,0);DMA_K(1,SLOTB);
  bf16x8 qr[4];
  #pragma unroll
  for(int d0=0;d0<4;++d0)qr[d0]=*reinterpret_cast<const bf16x8*>(&Qw[(size_t)r32*PW+d0*16+hi*8]);
  if(KIND==1){ const bf16x8 z={0,0,0,0,0,0,0,0}; if(pass==0){qr[2]=z;qr[3]=z;}else{qr[0]=z;qr[1]=z;} }
  float mhat=0.f,l_reg=0.f;f32x16 o[2];o[0]=f32x16{};o[1]=f32x16{};f32x16 negm=f32x16{};asm volatile("":"+v"(negm));
  #define NEGINF (-INFINITY)
  #define CMASK(P0,P1,t) do{ if(KIND!=1 && ud.lat && (t)>=4){ \
      if(KIND==0){ const int kp0_=ud.kpos0+64*((t)-4); \
        if(kp0_<0||kp0_>=SEQ){ _Pragma("unroll") for(int r=0;r<16;++r){P0[r]=NEGINF;P1[r]=NEGINF;} } \
        else { const int dlt_=kp0_-(ud.qpos0+32*wid); \
          if(dlt_<-97||dlt_>65){ const int d0_=dlt_-r32+4*hi+128; \
            _Pragma("unroll") for(int r=0;r<16;++r){ const int kk_=(r&3)+8*(r>>2); \
              if((unsigned)(d0_+kk_)>256u)P0[r]=NEGINF; if((unsigned)(d0_+kk_+32)>256u)P1[r]=NEGINF; } } } } \
      else { const int kr_=ud.kpos0+((t)-4), qr_=ud.qpos0+(wid>>1); const int rs_=min(max(qr_-4,0),24); \
        if(kr_<rs_||kr_>=rs_+8){ _Pragma("unroll") for(int r=0;r<16;++r){P0[r]=NEGINF;P1[r]=NEGINF;} } \
        else { const int qc_=32*(wid&1)+r32; const int cs_=min(max(qc_-8,0),48); \
          const float*br_=(const float*)(shm+LDS_BIAS)+64+(kr_-qr_+7)*31+15-qc_+4*hi; const int e0_=4*hi-cs_; \
          _Pragma("unroll") for(int r=0;r<16;++r){ const int kk_=(r&3)+8*(r>>2); \
            const float b0_=br_[kk_], b1_=br_[kk_+32]; \
            P0[r]=((unsigned)(e0_+kk_)<16u)?P0[r]+b0_:NEGINF; P1[r]=((unsigned)(e0_+kk_+32)<16u)?P1[r]+b1_:NEGINF; } } } } }while(0)
  bool resc=false;
  #define START(P0,P1) do{ const float rm=rowmax(P0,P1); resc=false; \
    { const float dl=rm; mhat=fadd_s(mhat,dl); \
      _Pragma("unroll") for(int r=0;r<16;++r){P0[r]=fsub_s(P0[r],dl);P1[r]=fsub_s(P1[r],dl);} \
      _Pragma("unroll") for(int r=0;r<16;++r)negm[r]=-mhat; asm volatile("":"+v"(negm)); } \
    _Pragma("unroll") for(int r=0;r<16;++r)P0[r]=__builtin_amdgcn_exp2f(P0[r]); }while(0)
  #define RESC() do{ if(resc){ asm volatile("s_waitcnt lgkmcnt(0)":::"memory"); \
      _Pragma("unroll") for(int d_=0;d_<2;++d_) _Pragma("unroll") for(int r=0;r<16;++r)o[d_][r]*=wsf[crow(r,hi)]; } }while(0)
  f32x16 pA0,pA1,pB0,pB1;
  int sl_prev=0,sl_cur=0,sl_next=SLOTB;
  #define ROT() do{sl_prev=sl_cur;sl_cur=sl_next;sl_next=(sl_next==(NSLOT-1)*SLOTB)?0:sl_next+SLOTB;}while(0)
  DMA_K(2,2*SLOTB);
  WAIT_BAR(3);
  qkt(pA0,pA1,Kbase,qr,negm,r32,hi);asm volatile("s_nop 15\n\ts_nop 7":"+v"(pA0),"+v"(pA1));
  START(pA0,pA1);
  _Pragma("unroll") for(int r=0;r<16;++r)pA1[r]=__builtin_amdgcn_exp2f(pA1[r]);
  WAIT_BAR(0);
  DMA_K(3,0);DMA_V(1,SLOTB);
  ROT();
  kload8(kf,kp0+sl_cur);
  WAIT_BAR(2);
  s16x4 vlo[8],vhi[8]; u32x4 pw0,pw1,pw2,pw3;
  #define PKW(P,B) cvtpk_s(P[B],P[B+1])
  #define PAF(k) __builtin_bit_cast(bf16x8,pw##k)
  #define VFR(i) (bf16x8){vlo[i][0],vlo[i][1],vlo[i][2],vlo[i][3],vhi[i][0],vhi[i][1],vhi[i][2],vhi[i][3]}
  #define PIN(x) asm volatile("":"+v"(x))
  #define MX3(a,b,c) __builtin_fmaxf(__builtin_fmaxf((a),(b)),(c))
  #define GAPA(MF,A0,A1,A2,A3,W0,W1,PW_) do{ MF; sacc+=A0; sacc+=A1; sacc+=A2; sacc+=A3; PIN(sacc); W0; W1; PIN(PW_); SBAR(); }while(0)
  #define EX(v) __builtin_amdgcn_exp2f(v)
  #define GAPB(MF,X,B) do{ MF; X[B]=EX(X[B]); X[B+1]=EX(X[B+1]); X[B+2]=EX(X[B+2]); X[B+3]=EX(X[B+3]); PIN(X); SBAR(); }while(0)
  #define VRD(i) do{ vlo[i]=vtr(vp_+(((i)>>2)*4096+((i)&3)*1024)); vhi[i]=vtr(vp_+(((i)>>2)*4096+((i)&3)*1024+512)); }while(0)
  #define KRD(G,j) do{ if(G){ kload2(kf,kp0+sl_next,j); SBAR(); } }while(0)
  #define STEP(C0,C1,P0,P1,t,GK,GV,GL) do{ SBAR(); \
    const lds_cptr vp_=vp0+sl_prev; \
    VRD(0); SBAR(); float sacc=(P0[0]+P0[1]); \
    GAPA(C0=__builtin_amdgcn_mfma_f32_32x32x16_bf16(kf[0],qr[0],negm,0,0,0), P0[2],P0[3],P0[4],P0[5],     pw0[0]=PKW(P0,0), pw0[1]=PKW(P0,2), pw0); \
    VRD(4); SBAR(); GAPA(C1=__builtin_amdgcn_mfma_f32_32x32x16_bf16(kf[1],qr[0],negm,0,0,0), P0[6],P0[7],P0[8],P0[9],     pw0[2]=PKW(P0,4), pw0[3]=PKW(P0,6), pw0); \
    VRD(1); SBAR(); GAPA(C0=__builtin_amdgcn_mfma_f32_32x32x16_bf16(kf[2],qr[1],C0,0,0,0),   P0[10],P0[11],P0[12],P0[13], pw1[0]=PKW(P0,8), pw1[1]=PKW(P0,10), pw1); \
    VRD(5); SBAR(); GAPA(C1=__builtin_amdgcn_mfma_f32_32x32x16_bf16(kf[3],qr[1],C1,0,0,0),   P0[14],P0[15],P1[0],P1[1],   pw1[2]=PKW(P0,12),pw1[3]=PKW(P0,14), pw1); \
    VRD(2); SBAR(); GAPA(C0=__builtin_amdgcn_mfma_f32_32x32x16_bf16(kf[4],qr[2],C0,0,0,0),   P1[2],P1[3],P1[4],P1[5],     pw2[0]=PKW(P1,0), pw2[1]=PKW(P1,2), pw2); \
    VRD(6); SBAR(); GAPA(C1=__builtin_amdgcn_mfma_f32_32x32x16_bf16(kf[5],qr[2],C1,0,0,0),   P1[6],P1[7],P1[8],P1[9],     pw2[2]=PKW(P1,4), pw2[3]=PKW(P1,6), pw2); \
    VRD(3); SBAR(); GAPA(C0=__builtin_amdgcn_mfma_f32_32x32x16_bf16(kf[6],qr[3],C0,0,0,0),   P1[10],P1[11],P1[12],P1[13], pw3[0]=PKW(P1,8), pw3[1]=PKW(P1,10), pw3); \
    VRD(7); SBAR(); GAPA(C1=__builtin_amdgcn_mfma_f32_32x32x16_bf16(kf[7],qr[3],C1,0,0,0),   P1[14],P1[15],0.f,0.f,       pw3[2]=PKW(P1,12),pw3[3]=PKW(P1,14), pw3); \
    l_reg+=sacc; \
    if(GK){DMA_K((t)+3,sl_cur);} if(GV){DMA_V((t)+1,sl_next);} \
    CMASK(C0,C1,t); \
    { float a=MX3(C0[0],C0[1],C1[0]),b=MX3(C0[2],C0[3],C1[1]); a=MX3(a,C1[2],C1[3]); \
      _Pragma("unroll") for(int r=4;r<16;r+=4){a=MX3(a,C0[r],C0[r+1]);b=MX3(b,C0[r+2],C0[r+3]);a=MX3(a,C1[r],C1[r+1]);b=MX3(b,C1[r+2],C1[r+3]);} \
      float rm=__builtin_fmaxf(a,b); { auto rr=__builtin_amdgcn_permlane32_swap(__float_as_uint(rm),__float_as_uint(rm),false,false); rm=__builtin_fmaxf(__uint_as_float(rr[0]),__uint_as_float(rr[1])); } \
      resc=false; \
      if(__builtin_expect(__any(rm>(float)THRL),0)){ const float dl=__builtin_fmaxf(rm,0.f); mhat+=dl; \
        _Pragma("unroll") for(int r=0;r<16;++r){C0[r]-=dl;C1[r]-=dl;} \
        _Pragma("unroll") for(int r=0;r<16;++r)negm[r]=-mhat; asm volatile("":"+v"(negm)); \
        const float f=__builtin_amdgcn_exp2f(-dl); l_reg*=f; if(hi==0)wsf[r32]=f; resc=true; } } \
    SBAR(); \
    GAPB(o[0]=__builtin_amdgcn_mfma_f32_32x32x16_bf16(PAF(0),VFR(0),o[0],0,0,0), C0,0); \
    GAPB(o[1]=__builtin_amdgcn_mfma_f32_32x32x16_bf16(PAF(0),VFR(4),o[1],0,0,0), C0,4); \
    KRD(GL,0); GAPB(o[0]=__builtin_amdgcn_mfma_f32_32x32x16_bf16(PAF(1),VFR(1),o[0],0,0,0), C0,8); \
    KRD(GL,1); GAPB(o[1]=__builtin_amdgcn_mfma_f32_32x32x16_bf16(PAF(1),VFR(5),o[1],0,0,0), C0,12); \
    KRD(GL,2); GAPB(o[0]=__builtin_amdgcn_mfma_f32_32x32x16_bf16(PAF(2),VFR(2),o[0],0,0,0), C1,0); \
    KRD(GL,3); GAPB(o[1]=__builtin_amdgcn_mfma_f32_32x32x16_bf16(PAF(2),VFR(6),o[1],0,0,0), C1,4); \
    GAPB(o[0]=__builtin_amdgcn_mfma_f32_32x32x16_bf16(PAF(3),VFR(3),o[0],0,0,0), C1,8); \
    GAPB(o[1]=__builtin_amdgcn_mfma_f32_32x32x16_bf16(PAF(3),VFR(7),o[1],0,0,0), C1,12); \
    }while(0)
  int t=1;
  for(;t+5<NT;t+=2){
    STEP(pB0,pB1,pA0,pA1,t,true,true,true);     WAIT_BAR(2); RESC(); ROT();
    STEP(pA0,pA1,pB0,pB1,t+1,true,true,true);   WAIT_BAR(2); RESC(); ROT();
  }
  #define ENDW(tt) do{ if((tt)+3<NT){WAIT_BAR(2);} else if((tt)+2<NT){WAIT_BAR(1);} else {WAIT_BAR(0);} }while(0)
  for(;t+1<NT;t+=2){
    STEP(pB0,pB1,pA0,pA1,t,(t+3<NT),(t+1<NT),(t+1<NT));       ENDW(t);   RESC(); ROT();
    STEP(pA0,pA1,pB0,pB1,t+1,(t+4<NT),(t+2<NT),(t+2<NT));     ENDW(t+1); RESC(); ROT();
  }
  STEP(pB0,pB1,pA0,pA1,NT-1,false,false,false); RESC();
  { float sacc=pB0[0]+pB0[1]; _Pragma("unroll") for(int r=2;r<16;++r)sacc+=pB0[r]; _Pragma("unroll") for(int r=0;r<16;++r)sacc+=pB1[r]; l_reg+=sacc;
    pw0=(u32x4){PKW(pB0,0),PKW(pB0,2),PKW(pB0,4),PKW(pB0,6)};pw1=(u32x4){PKW(pB0,8),PKW(pB0,10),PKW(pB0,12),PKW(pB0,14)};pw2=(u32x4){PKW(pB1,0),PKW(pB1,2),PKW(pB1,4),PKW(pB1,6)};pw3=(u32x4){PKW(pB1,8),PKW(pB1,10),PKW(pB1,12),PKW(pB1,14)};
    SBAR(); pv(o,vb0+sl_cur,PAF(0),PAF(1),PAF(2),PAF(3)); }
  #undef PKW
  #undef PAF
  #undef VFR
  #undef PIN
  #undef MX3
  #undef GAPA
  #undef GAPB
  #undef EX
  #undef VRD
  #undef KRD
  #undef STEP
  #undef ENDW
  {auto rr=__builtin_amdgcn_permlane32_swap(__float_as_uint(l_reg),__float_as_uint(l_reg),false,false);l_reg=__uint_as_float(rr[0])+__uint_as_float(rr[1]);}
  if(KIND==0)l_reg+=__builtin_amdgcn_exp2f(ud.sink2-mhat);
  if(hi==0)wsf[32+r32]=l_reg;asm volatile("s_waitcnt lgkmcnt(0)":::"memory");
  float rli[16];
  #pragma unroll
  for(int r=0;r<16;++r)rli[r]=__builtin_amdgcn_rcpf(wsf[32+crow(r,hi)]);
  bf16*Ow=ud.o+(size_t)(ud.qrow0+wid*QBLK)*1024;
  if(KIND!=1){ bf16*stg=(bf16*)stgf;
    #pragma unroll
    for(int r=0;r<16;++r){const int orow=crow(r,hi);
      #pragma unroll
      for(int d0=0;d0<2;++d0)stg[orow*64+d0*32+r32]=__float2bfloat16(o[d0][r]*rli[r]);}
    asm volatile("s_waitcnt lgkmcnt(0)":::"memory");
    #pragma unroll
    for(int i=0;i<4;++i){const int row=i*8+(lane>>3),ch=lane&7; const u32x4 v=*(const u32x4*)(stg+row*64+ch*8); *(u32x4*)(Ow+(size_t)row*1024+ch*8)=v;} }
  else if(pass==0){
    #pragma unroll
    for(int r=0;r<16;++r){const int orow=crow(r,hi);
      #pragma unroll
      for(int d0=0;d0<2;++d0)stgf[orow*64+d0*32+r32]=o[d0][r]*rli[r];}
  } else {
    #pragma unroll
    for(int r=0;r<16;++r){const int orow=crow(r,hi);
      #pragma unroll
      for(int d0=0;d0<2;++d0){ const int a_=orow*64+d0*32+r32; stgf[a_]=stgf[a_]-ud.lam*(o[d0][r]*rli[r]); } }
    asm volatile("s_waitcnt lgkmcnt(0)":::"memory");
    #pragma unroll
    for(int i=0;i<4;++i){const int row=i*8+(lane>>3),ch=lane&7;
      const f32x4 a=*(const f32x4*)(stgf+row*64+ch*8), b=*(const f32x4*)(stgf+row*64+ch*8+4);
      float ss=(a[0]*a[0]+a[1]*a[1])+(a[2]*a[2]+a[3]*a[3])+(b[0]*b[0]+b[1]*b[1])+(b[2]*b[2]+b[3]*b[3]);
      ss+=__shfl_xor(ss,1); ss+=__shfl_xor(ss,2); ss+=__shfl_xor(ss,4);
      const float sc=ud.onem/sqrtf(ss*(1.0f/64.0f)+1e-5f);
      const f32x4 g0=*(const f32x4*)(ud.subg+ch*8), g1=*(const f32x4*)(ud.subg+ch*8+4);
      u32x4 v; v.x=cvtpk_s(a[0]*sc*g0[0],a[1]*sc*g0[1]); v.y=cvtpk_s(a[2]*sc*g0[2],a[3]*sc*g0[3]); v.z=cvtpk_s(b[0]*sc*g1[0],b[1]*sc*g1[1]); v.w=cvtpk_s(b[2]*sc*g1[2],b[3]*sc*g1[3]);
      *(u32x4*)(Ow+(size_t)row*1024+ch*8)=v; } }
  asm volatile("s_waitcnt lgkmcnt(0)\n\ts_barrier":::"memory");
  #undef START
  #undef RESC
  #undef ROT
  #undef CMASK
  #undef NEGINF
  }
  #undef DMA_K
  #undef DMA_V
  #undef TROW
}
struct PhaseArgs { const bf16* P; bf16* MIX; const float* sink; const float* nab; const float* subg; float lam, onem; bool do_ctx; int kinds; };
template<int KIND,int THRL> __device__ __forceinline__ void run_unit(const PhaseArgs& A,char*lds,int b,int h,int qb,bool lat){
  UD ud;
  const int qc=KIND==0?C_AQ+h*64:(KIND==1?C_BQ+h*64:C_CQ+h*64);
  const int kc=KIND==0?C_AK+(h/3)*64:(KIND==1?C_BK+h*64:C_CK+h*64);
  const int vc=KIND==0?C_AV+(h/3)*64:(KIND==1?C_BV+h*64:C_CV+h*64);
  const int mc=KIND==0?M_A+h*64:(KIND==1?M_B+h*64:M_C+h*64);
  ud.q=A.P+qc; ud.k=A.P+kc; ud.v=A.P+vc; ud.o=A.MIX+mc;
  ud.ctx_row0=MLAT+b*CTXL; ud.lat_lo=b*SEQ; ud.lat_hi=b*SEQ+SEQ-64; ud.lat=lat;
  ud.sink2=0.f; ud.lam=A.lam; ud.onem=A.onem; ud.subg=A.subg; ud.nab=A.nab+h*465;
  if(KIND==0)ud.sink2=A.sink[h]*1.4426950408889634f;
  if(lat){ ud.qrow0=b*SEQ+qb*256;
    if(KIND==0){ ud.lat_row0=b*SEQ+qb*256-128; ud.NT=12; ud.kpos0=qb*256-128; ud.qpos0=qb*256; }
    else if(KIND==1){ ud.lat_row0=b*SEQ; ud.NT=36; ud.kpos0=0; ud.qpos0=0; }
    else { const int R0=4*qb, st=min(max(R0-4,0),24); ud.lat_row0=b*SEQ+st*64; ud.NT=16; ud.kpos0=st; ud.qpos0=R0; } }
  else { ud.qrow0=MLAT+b*CTXL; ud.lat_row0=b*SEQ; ud.NT=4; ud.kpos0=0; ud.qpos0=0; }
  attn_unit<KIND,THRL>(ud,lds);
}
template<int THRL=8> __device__ __forceinline__ void attn_phase(char*lds,int vcu,int G,const PhaseArgs& A){
  #pragma unroll 1
  for(int v=vcu;v<256;v+=G){
    const int b=v>>5,j=v&31,p=j>>1,odd=j&1;
    #pragma unroll 1
    for(int s=0;s<5;++s){
      int kind,h,qb=0; bool lat=true;
      if(s==0){ kind=1; h=j>>3; qb=j&7; }
      else if(s<4){ const int i=s-1;
        const bool isA = odd ? (i==0) : (i<2);
        const int u = odd ? (i==0 ? 3*p+2 : 3*p+i) : (i<2 ? 3*p+i : 3*p);
        kind=isA?0:2; h=u>>3; qb=u&7; }
      else { if(!A.do_ctx||odd)continue; lat=false;
        if(p<6){kind=0;h=p;} else if(p<12){kind=2;h=p-6;} else {kind=1;h=p-12;} }
      if(!((A.kinds>>kind)&1))continue;
      if(kind==0)run_unit<0,THRL>(A,lds,b,h,qb,lat); else if(kind==1)run_unit<1,THRL>(A,lds,b,h,qb,lat); else run_unit<2,THRL>(A,lds,b,h,qb,lat);
    }
  }
}
#undef SBAR
#undef WAIT_BAR
}

#ifndef ATT_KINDS
#define ATT_KINDS 7
#endif
constexpr int PH_P0A = 0, PH_P0B = 1, PH_L0 = 2, PH_PER_LAYER = 8, PH_END = PH_L0 + DEPTH * PH_PER_LAYER;
struct Args { const float* in[N_IN]; float* out; unsigned char* ws; int ph_lo, ph_hi; };
__global__ void __launch_bounds__(NWAVES * 64, 2) skel_fwd(Args args) {
    extern __shared__ __attribute__((aligned(16))) unsigned char lds[];
    Frame F;
    F.lds = (LAS unsigned char*)lds;
    F.MISC = (volatile LAS unsigned*)(F.lds + MISC_OFF);
    F.tid = threadIdx.x; F.lane = F.tid & 63; F.wave = __builtin_amdgcn_readfirstlane(F.tid >> 6);
    F.G = gridDim.x; { const int bx = blockIdx.x; F.vcu = (F.G % 8 == 0) ? (bx % 8) * (F.G / 8) + bx / 8 : bx; }
    F.ws = args.ws; F.out = args.out; F.ctl = (gu32*)(args.ws + WS_CTL);
#pragma unroll
    for (int i = 0; i < N_IN; ++i) F.in[i] = args.in[i];
    for (int u = F.tid; u < (LDS_BYTES - LDSCTL_OFF) / 4; u += NWAVES * 64) ((LAS unsigned*)(F.lds + LDSCTL_OFF))[u] = 0u;
    __syncthreads();
    const int lo = args.ph_lo, hi = args.ph_hi;
    const bool multi = (hi - lo) > 1;
    XcdBarrier bar; bar.bar = (unsigned*)(F.ctl + CW_BAR); bar.x = 0; bar.st = nullptr;
    if (multi) bar = xcd_barrier_post((unsigned*)(F.ctl + CW_BAR), F.MISC + 8);
#define IN(k) (lo <= (k) && (k) < hi)
#define SEAM(k) do { if (IN(k) && IN((k) + 1)) xcd_barrier(bar); } while (0)
    const float* MOD = (const float*)(F.ws + WS_MOD); const float* TAB = (const float*)(F.ws + WS_TAB);
    bf16* HA = (bf16*)(F.ws + WS_HA); bf16* P = (bf16*)(F.ws + WS_P); bf16* MIX = (bf16*)(F.ws + WS_MIX); bf16* HID = (bf16*)(F.ws + WS_HID);
    float* RC = (float*)(F.ws + WS_RC);

    if (IN(PH_P0A)) { p0a_prologue(F); } SEAM(PH_P0A);
    if (IN(PH_P0B)) { p0b_modulate(F); } SEAM(PH_P0B);
#pragma unroll 1
    for (int l = 0; l < DEPTH; ++l) {
        const int pb = PH_L0 + l * PH_PER_LAYER; const bool last = (l == DEPTH - 1);
        const unsigned char* wl = F.ws + WS_W + (size_t)l * W_LAYER; const float* modl = MOD + (size_t)l * 9 * NMOD;
        const int Mrest = last ? MLAT : MALL;
        if (IN(pb + 0)) {
            pg8::Gemm g{HA, (const bf16*)(wl + W_IN), MALL, PW, D}; pg8::StaticOrder S; S.init(MALL, PW, F.G, (int)blockIdx.x);
            pg8::EpiProj E{P, PW, TAB + TAB_CSCALE};
            pg8::gemm_phase<pg8::EpiProj, pg8::StaticOrder, PG8_ALIGN, PG8_SP2>(F.lds + RING_OFF, g, S, E);
        } SEAM(pb + 0);
        if (IN(pb + 1)) { rope_pass(F); } SEAM(pb + 1);
        if (IN(pb + 2)) {
            const float* sink = F.in[I_SINK] + l * 6; const float* nab = F.in[I_NAB] + l * 6 * 15 * 31; const float* subg = F.in[I_SUBG] + l * 64; const float* scal = TAB + TAB_SCAL + 4 * l;
            if (ATT_KINDS) { att::PhaseArgs A{(const att::bf16*)P, (att::bf16*)MIX, sink, nab, subg, scal[0], scal[1], l == 0, ATT_KINDS};
                att::attn_phase<8>((char*)lds + RING_OFF, F.vcu, F.G, A); }
            if (!(ATT_KINDS & 1)) { naive::attn_phase<0>(F.lds, F.vcu, F.G, P, MIX, sink, nab, scal, subg); __syncthreads(); if (l == 0) { naive::attn_phase<1>(F.lds, F.vcu, F.G, P, MIX, sink, nab, scal, subg); __syncthreads(); } }
            if (!(ATT_KINDS & 2)) { naive::attn_phase<2>(F.lds, F.vcu, F.G, P, MIX, sink, nab, scal, subg); __syncthreads(); if (l == 0) { naive::attn_phase<3>(F.lds, F.vcu, F.G, P, MIX, sink, nab, scal, subg); __syncthreads(); } }
            if (!(ATT_KINDS & 4)) { naive::attn_phase<4>(F.lds, F.vcu, F.G, P, MIX, sink, nab, scal, subg); __syncthreads(); if (l == 0) { naive::attn_phase<5>(F.lds, F.vcu, F.G, P, MIX, sink, nab, scal, subg); __syncthreads(); } }
        } SEAM(pb + 2);
        if (IN(pb + 3)) {
            pg8::Gemm g{MIX, (const bf16*)(wl + W_O), Mrest, D, D}; pg8::StaticOrder S; S.init(Mrest, D, F.G, (int)blockIdx.x);
            pg8::EpiRes E{l == 0 ? F.in[I_X] : F.out, l == 0 ? F.in[I_CTX] : RC, F.out, RC, modl, 2 * D, ALPHA};
            pg8::gemm_phase<pg8::EpiRes, pg8::StaticOrder, PG8_ALIGN, PG8_SP2>(F.lds + RING_OFF, g, S, E);
        } SEAM(pb + 3);
        if (IN(pb + 4)) { ln_pass(F, Mrest, F.in[I_LN1G] + l * D, F.in[I_LN1B] + l * D, modl, 3 * D); } SEAM(pb + 4);
        if (IN(pb + 5)) {
            pg8::Gemm g{HA, (const bf16*)(wl + W_FI), Mrest, 2 * FF, D}; pg8::StaticOrder S; S.init(Mrest, 2 * FF, F.G, (int)blockIdx.x);
            pg8::EpiSwiglu E{HID, FF};
            pg8::gemm_phase<pg8::EpiSwiglu, pg8::StaticOrder, PG8_ALIGN, PG8_SP2>(F.lds + RING_OFF, g, S, E);
        } SEAM(pb + 5);
        if (IN(pb + 6)) {
            pg8::Gemm g{HID, (const bf16*)(wl + W_FO), Mrest, D, FF}; pg8::StaticOrder S; S.init(Mrest, D, F.G, (int)blockIdx.x);
            pg8::EpiRes E{F.out, RC, F.out, RC, modl, 5 * D, ALPHA};
            pg8::gemm_phase<pg8::EpiRes, pg8::StaticOrder, PG8_ALIGN, PG8_SP2>(F.lds + RING_OFF, g, S, E);
        } SEAM(pb + 6);
        if (IN(pb + 7)) { ln_pass(F, Mrest, F.in[I_LN2G] + l * D, F.in[I_LN2B] + l * D, last ? nullptr : modl + 9 * NMOD, 0); } SEAM(pb + 7);
    }
#undef IN
#undef SEAM
}

extern "C" void kernel_launch(void* const* d_in, const int* in_sizes, int n_in, void* d_out, int out_size, void* d_ws, size_t ws_size, hipStream_t stream) {
    static int grid = 0;
    if (grid == 0) {
        if (n_in != N_IN || in_sizes[0] != MLAT * D || out_size != MLAT * D || ws_size < WS_END) { fprintf(stderr, "kernel_launch: unexpected shapes (n_in %d, in0 %d, out %d, ws %zu); nothing launched\n", n_in, n_in > 0 ? in_sizes[0] : -1, out_size, ws_size); grid = -1; return; }
        int dev = 0, cus = 0, per_cu = 0;
        if (hipGetDevice(&dev) != hipSuccess || hipDeviceGetAttribute(&cus, hipDeviceAttributeMultiprocessorCount, dev) != hipSuccess) { grid = -1; return; }
        if (hipFuncSetAttribute((const void*)skel_fwd, hipFuncAttributeMaxDynamicSharedMemorySize, LDS_BYTES) != hipSuccess) { fprintf(stderr, "kernel_launch: hipFuncSetAttribute failed\n"); grid = -1; return; }
        if (hipOccupancyMaxActiveBlocksPerMultiprocessor(&per_cu, (const void*)skel_fwd, NWAVES * 64, LDS_BYTES) != hipSuccess || per_cu < 1) { fprintf(stderr, "kernel_launch: occupancy query reports %d\n", per_cu); per_cu = 1; }
        (void)hipGetLastError();
        grid = cus;
    }
    if (grid < 0) return;
    (void)hipMemsetAsync((char*)d_ws + WS_CTL, 0, CTL_ZERO_BYTES, stream);
    Args a{};
    for (int i = 0; i < N_IN; ++i) a.in[i] = (const float*)d_in[i];
    a.out = (float*)d_out; a.ws = (unsigned char*)d_ws;
    a.ph_lo = 0; a.ph_hi = PH_END;
    hipLaunchKernelGGL(skel_fwd, dim3(grid), dim3(NWAVES * 64), LDS_BYTES, stream, a);
}
```
